# Optimizing an MI355X kernel written in HIP

```python
import math
import jax, jax.numpy as jnp
from jax import lax
import numpy as np

D_MODEL = 1024
BATCH = 8
SEQ = 4096
DEPTH = 1

GRID_W = 64
D_RNN = 1024
RNN_BLOCKS = 16
RNN_BW = D_RNN // RNN_BLOCKS
CONV_W = 4
CONV_LEFT = 2
LRU_C = 8.0
N_HEADS = 16
N_KV = 4
GROUP = N_HEADS // N_KV
HEAD_DIM = 64
ROPE_THETA = 10000.0
AXIS_PAIRS = HEAD_DIM // 4
Q_BLOCK = 128
D_FF = ((8 * D_MODEL // 3 + 255) // 256) * 256
EPS = 1e-6

IN_SIZES = (D_RNN, D_RNN, N_HEADS * HEAD_DIM, N_KV * HEAD_DIM, N_KV * HEAD_DIM, D_MODEL, D_MODEL)
IN_SPLITS = tuple(int(v) for v in np.cumsum(IN_SIZES)[:-1])
D_IN = int(sum(IN_SIZES))

kernel_name = "hybrid_rglru_axial_gqa_gated_block"


def _rmsnorm(x, g):
    xf = x.astype(jnp.float32)
    y = xf * lax.rsqrt(jnp.mean(xf * xf, axis=-1, keepdims=True) + EPS)
    return (y * g.astype(jnp.float32)).astype(x.dtype)


def _centred_dwconv(x, w, b):
    s = x.shape[1]
    xp = jnp.pad(x, ((0, 0), (CONV_LEFT, CONV_W - 1 - CONV_LEFT), (0, 0)))
    return sum(xp[:, k:k + s, :] * w[k] for k in range(CONV_W)) + b


def _block_diag(x, w, b):
    bsz, s, _ = x.shape
    xh = x.reshape(bsz, s, RNN_BLOCKS, RNN_BW)
    return jnp.einsum('bshi,hij->bshj', xh, w).reshape(bsz, s, D_RNN) + b


def _lru_combine(left, right):
    a1, b1 = left
    a2, b2 = right
    return a1 * a2, a2 * b1 + b2


def _rglru(xc, wa, ba, wx, bx, lam, reverse):
    r = jax.nn.sigmoid(_block_diag(xc, wa, ba)).astype(jnp.float32)
    i = jax.nn.sigmoid(_block_diag(xc, wx, bx)).astype(jnp.float32)
    log_a = -LRU_C * r * jax.nn.softplus(-lam.astype(jnp.float32))
    a = jnp.exp(log_a)
    mult = jnp.sqrt(-jnp.expm1(2.0 * log_a))
    bterm = mult * (i * xc.astype(jnp.float32))
    _, h = lax.associative_scan(_lru_combine, (a, bterm), axis=1, reverse=reverse)
    return h


def _axial_rope_angles(s):
    rows = s // GRID_W
    row = jnp.repeat(jnp.arange(rows, dtype=jnp.float32), GRID_W)
    col = jnp.tile(jnp.arange(GRID_W, dtype=jnp.float32), rows)
    inv_freq = ROPE_THETA ** (-(2.0 * jnp.arange(AXIS_PAIRS, dtype=jnp.float32)) / (2.0 * AXIS_PAIRS))
    ang = jnp.concatenate([row[:, None] * inv_freq, col[:, None] * inv_freq], axis=-1)
    return jnp.cos(ang), jnp.sin(ang)


def _apply_rope(x, cos, sin):
    xf = x.astype(jnp.float32).reshape(x.shape[:-1] + (HEAD_DIM // 2, 2))
    x0, x1 = xf[..., 0], xf[..., 1]
    c = cos[None, :, None, :]
    s = sin[None, :, None, :]
    out = jnp.stack([x0 * c - x1 * s, x0 * s + x1 * c], axis=-1)
    return out.reshape(x.shape).astype(x.dtype)


def _attend(q, k, v):
    bsz, s = q.shape[:2]
    nb = s // Q_BLOCK
    scale = 1.0 / math.sqrt(HEAD_DIM)
    qb = q.reshape(bsz, nb, Q_BLOCK, N_KV, GROUP, HEAD_DIM).transpose(1, 0, 2, 3, 4, 5)

    def one_block(qblk):
        sc = jnp.einsum('bqkgd,bskd->bkgqs', qblk, k).astype(jnp.float32) * scale
        p = jax.nn.softmax(sc, axis=-1).astype(v.dtype)
        return jnp.einsum('bkgqs,bskd->bqkgd', p, v)

    o = lax.map(one_block, qb)
    return o.transpose(1, 0, 2, 3, 4, 5).reshape(bsz, s, N_HEADS * HEAD_DIM)


def setup_inputs(seed: int = 0) -> dict:
    key = jax.random.key(seed)
    ks = jax.random.split(key, 32)
    n = lambda k, shape, fan: jax.random.normal(k, shape, jnp.float32) * (fan ** -0.5)
    small = lambda k, shape: 0.01 * jax.random.normal(k, shape, jnp.float32)

    def lru_lambda(k):
        a0 = jax.random.uniform(k, (D_RNN,), jnp.float32, 0.9, 0.999)
        sg = a0 ** (1.0 / LRU_C)
        return jnp.log(sg) - jnp.log1p(-sg)

    return {
        "x": jax.random.normal(ks[0], (BATCH, SEQ, D_MODEL), jnp.float32),
        "norm1_g": 1.0 + small(ks[1], (D_MODEL,)),
        "w_in": n(ks[2], (D_MODEL, D_IN), D_MODEL),
        "conv_w": n(ks[3], (CONV_W, D_RNN), CONV_W),
        "conv_b": small(ks[4], (D_RNN,)),
        "wa_f": n(ks[5], (RNN_BLOCKS, RNN_BW, RNN_BW), RNN_BW),
        "ba_f": small(ks[6], (D_RNN,)),
        "wx_f": n(ks[7], (RNN_BLOCKS, RNN_BW, RNN_BW), RNN_BW),
        "bx_f": small(ks[8], (D_RNN,)),
        "lam_f": lru_lambda(ks[9]),
        "wa_b": n(ks[10], (RNN_BLOCKS, RNN_BW, RNN_BW), RNN_BW),
        "ba_b": small(ks[11], (D_RNN,)),
        "wx_b": n(ks[12], (RNN_BLOCKS, RNN_BW, RNN_BW), RNN_BW),
        "bx_b": small(ks[13], (D_RNN,)),
        "lam_b": lru_lambda(ks[14]),
        "q_norm_g": 1.0 + small(ks[15], (HEAD_DIM,)),
        "k_norm_g": 1.0 + small(ks[16], (HEAD_DIM,)),
        "p_rnn": n(ks[17], (D_RNN, D_MODEL), D_RNN),
        "p_attn": n(ks[18], (N_HEADS * HEAD_DIM, D_MODEL), N_HEADS * HEAD_DIM),
        "w_o": n(ks[19], (D_MODEL, D_MODEL), D_MODEL),
        "norm2_g": 1.0 + small(ks[20], (D_MODEL,)),
        "w_ffn_in": n(ks[21], (D_MODEL, 2 * D_FF), D_MODEL),
        "w_ffn_out": n(ks[22], (D_FF, D_MODEL), D_FF),
    }


def reference(x, norm1_g, w_in, conv_w, conv_b, wa_f, ba_f, wx_f, bx_f, lam_f,
              wa_b, ba_b, wx_b, bx_b, lam_b, q_norm_g, k_norm_g, p_rnn, p_attn,
              w_o, norm2_g, w_ffn_in, w_ffn_out):
    bsz, s, _ = x.shape
    cos, sin = _axial_rope_angles(s)
    for _ in range(DEPTH):
        u = _rmsnorm(x, norm1_g)
        proj = u @ w_in
        rnn_x, rnn_gate, q, k, v, g_rnn, g_attn = jnp.split(proj, IN_SPLITS, axis=-1)

        xc = _centred_dwconv(rnn_x, conv_w, conv_b)
        h = (_rglru(xc, wa_f, ba_f, wx_f, bx_f, lam_f, reverse=False)
             + _rglru(xc, wa_b, ba_b, wx_b, bx_b, lam_b, reverse=True)).astype(x.dtype)
        y_rnn = (h * jax.nn.gelu(rnn_gate)) @ p_rnn

        q = q.reshape(bsz, s, N_HEADS, HEAD_DIM)
        k = k.reshape(bsz, s, N_KV, HEAD_DIM)
        v = v.reshape(bsz, s, N_KV, HEAD_DIM)
        q = _apply_rope(_rmsnorm(q, q_norm_g), cos, sin)
        k = _apply_rope(_rmsnorm(k, k_norm_g), cos, sin)
        y_attn = _attend(q, k, v) @ p_attn

        merged = jax.nn.sigmoid(g_rnn) * y_rnn + jax.nn.sigmoid(g_attn) * y_attn
        x = x + merged @ w_o

        v2 = _rmsnorm(x, norm2_g)
        a, up = jnp.split(v2 @ w_ffn_in, 2, axis=-1)
        x = x + (jax.nn.silu(a) * up) @ w_ffn_out
    return x
```

```cpp
#include <hip/hip_runtime.h>
#include <hip/hip_bf16.h>
#include <cstdio>
#include <cstdint>
#include <cmath>

#ifndef MK_N_LAUNCHES
#define MK_N_LAUNCHES 7
#endif

namespace pg8 {
#define PG8_LAS __attribute__((address_space(3)))
typedef unsigned short bf16_t;
typedef short bf16x8 __attribute__((ext_vector_type(8)));
typedef float f32x4 __attribute__((ext_vector_type(4)));
typedef unsigned u32x4 __attribute__((ext_vector_type(4)));
typedef unsigned u32x2 __attribute__((ext_vector_type(2)));
constexpr int BM = 256, BK = 64, HALF = 128, HTB = HALF * BK * 2  , STAGE_BYTES = 8 * HTB, NXCD = 8, WGM = 8;

__host__ __device__ __forceinline__ int lds_byte(int r, int c) { const int st = (r >> 4) * 2 + (c >> 5), rr = r & 15, cc = c & 31, ob = rr * 64 + cc * 2; return st * 1024 + (ob ^ (((ob >> 9) & 1) << 5)); }
__host__ __device__ __forceinline__ void stage_rc(int b, int& R, int& C) { const int st = b / 1024, sb = b % 1024, swz = sb ^ (((sb >> 9) & 1) << 5); R = (st >> 1) * 16 + swz / 64; C = (st & 1) * 32 + (swz % 64) / 2; }
__host__ __device__ __forceinline__ int perm32(int rho) { const int n = rho >> 4, i = rho & 15; return 8 * (i >> 2) + 4 * n + (i & 3); }

struct Unit { int pm, pn, z; };
struct Gemm { const bf16_t *A0, *A1, *B0, *B1; int M, N, K; };

struct StaticOrder {
    int nM, nN, nwg, G, c;
    __host__ __device__ void init(int M, int N, int G_, int c_) { nM = M / BM; nN = N / BM; nwg = nM * nN; G = G_; c = c_; }
    __host__ __device__ bool next(int i, Unit& u) const {
        const long L = (long)i * G + c; if (L >= nwg) return false;
        int wgid = (int)L; { const int q = nwg / NXCD, r = nwg % NXCD, xcd = wgid % NXCD, off = wgid / NXCD; wgid = (xcd < r ? xcd * (q + 1) : r * (q + 1) + (xcd - r) * q) + off; }
        const int nig = WGM * nN, gid = wgid / nig, fm = gid * WGM, gsz = (nM - fm) < WGM ? (nM - fm) : WGM;
        u.pm = fm + ((wgid % nig) % gsz); u.pn = (wgid % nig) / gsz; u.z = 0; return true;
    }
    __device__ __forceinline__ void a_ready(const Unit&) const {}
    __device__ __forceinline__ void done(const Unit&) const {}
};
struct PairOrder : StaticOrder {
    __host__ __device__ bool next(int i, Unit& u) const { const bool ok = StaticOrder::next(i >> 1, u); u.z = i & 1; return ok; }
};

typedef float f32x2_t __attribute__((ext_vector_type(2))); typedef __bf16 bf16x2_t __attribute__((ext_vector_type(2)));
__device__ __forceinline__ unsigned cvt_pk_bf16(float lo, float hi) { f32x2_t v = {lo, hi}; bf16x2_t b = __builtin_convertvector(v, bf16x2_t); return __builtin_bit_cast(unsigned, b); }
__device__ __forceinline__ float bf_lo(unsigned w) { return __uint_as_float(w << 16); }
__device__ __forceinline__ float bf_hi(unsigned w) { return __uint_as_float(w & 0xffff0000u); }
__device__ __forceinline__ float sigmoid_f(float v) { return __builtin_amdgcn_rcpf(1.0f + __builtin_amdgcn_exp2f(-1.4426950408889634f * v)); }
__device__ __forceinline__ float gelu_tanh_f(float v) { const float u = v * (1.0f + 0.044715f * v * v); return v * __builtin_amdgcn_rcpf(1.0f + __builtin_amdgcn_exp2f(-2.302208198f * u)); }
__device__ __forceinline__ u32x4 pack8(f32x4 v0, f32x4 v1) { u32x4 w; w.x = cvt_pk_bf16(v0[0], v0[1]); w.y = cvt_pk_bf16(v0[2], v0[3]); w.z = cvt_pk_bf16(v1[0], v1[1]); w.w = cvt_pk_bf16(v1[2], v1[3]); return w; }
constexpr float NORM_EPS = 1e-6f;
constexpr float ATT_C2 = 0.125f * 1.4426950408889634f;

struct EpiProj {
    static constexpr bool PERM = true, AFTER_DRAIN = false;
    bf16_t *RX, *GG, *Q, *K, *V, *SR, *SA; const float *gq, *gk; const float* rope;
    __device__ __forceinline__ bool keep(const Unit&) const { return false; }
    template <int ACT> __device__ __forceinline__ void ew(f32x4 (&acc)[2][2][4][2], bf16_t* base, int ldc, int row0, int col0) const {
#pragma unroll
        for (int ai = 0; ai < 2; ++ai)
#pragma unroll
            for (int m = 0; m < 4; ++m) { bf16_t* rowp = base + (size_t)(row0 + ai * HALF + m * 16) * ldc + col0;
#pragma unroll
                for (int bj = 0; bj < 2; ++bj) { f32x4 v0 = acc[ai][bj][m][0], v1 = acc[ai][bj][m][1];
                    if (ACT == 1) {
#pragma unroll
                        for (int j = 0; j < 4; ++j) { v0[j] = gelu_tanh_f(v0[j]); v1[j] = gelu_tanh_f(v1[j]); } }
                    if (ACT == 2) {
#pragma unroll
                        for (int j = 0; j < 4; ++j) { v0[j] = sigmoid_f(v0[j]); v1[j] = sigmoid_f(v1[j]); } }
                    *(u32x4*)(rowp + bj * HALF) = pack8(v0, v1); }
                asm volatile("" ::: "memory"); }
    }
    __device__ __forceinline__ void heads(f32x4 (&acc)[2][2][4][2], bf16_t* base, int ldc, int head, const float* g, float scale, int row0, int fq) const {
        f32x4 gv[2][2];
#pragma unroll
        for (int bj = 0; bj < 2; ++bj)
#pragma unroll
            for (int n = 0; n < 2; ++n) gv[bj][n] = *(const f32x4*)(g + 32 * bj + 8 * fq + 4 * n);
#pragma unroll
        for (int ai = 0; ai < 2; ++ai)
#pragma unroll
            for (int m = 0; m < 4; ++m) {
                const int row = row0 + ai * HALF + m * 16, s = row & 4095, rp = s >> 6, cp = s & 63;
                float ss = 0.f;
#pragma unroll
                for (int bj = 0; bj < 2; ++bj)
#pragma unroll
                    for (int n = 0; n < 2; ++n) { const f32x4 v = acc[ai][bj][m][n]; ss += (v[0] * v[0] + v[1] * v[1]) + (v[2] * v[2] + v[3] * v[3]); }
                ss += __shfl_xor(ss, 16); ss += __shfl_xor(ss, 32);
                const float rstd = __builtin_amdgcn_rsqf(ss * (1.0f / 64.0f) + NORM_EPS) * scale;
                bf16_t* rowp = base + (size_t)row * ldc + head * 64 + 8 * fq;
#pragma unroll
                for (int bj = 0; bj < 2; ++bj) {
                    const int pos = bj == 0 ? rp : cp;
                    const f32x4* tp = (const f32x4*)(rope + (size_t)(pos * 16 + 4 * fq) * 2);
                    const f32x4 t0 = tp[0], t1 = tp[1];
                    f32x4 o[2];
#pragma unroll
                    for (int n = 0; n < 2; ++n) { const f32x4 v = acc[ai][bj][m][n] * gv[bj][n] * rstd; const f32x4 t = n ? t1 : t0;
                        o[n] = (f32x4){v[0] * t[0] - v[1] * t[1], v[0] * t[1] + v[1] * t[0], v[2] * t[2] - v[3] * t[3], v[2] * t[3] + v[3] * t[2]}; }
                    *(u32x4*)(rowp + 32 * bj) = pack8(o[0], o[1]); }
                asm volatile("" ::: "memory");
            }
    }
    __device__ __forceinline__ void operator()(f32x4 (&acc)[2][2][4][2], const Unit& u, int wr, int wc, int fr, int fq) const {
        const int pn = u.pn, row0 = u.pm * BM + wr * 64 + fr, cpos = wc * 32 + 8 * fq;
        if (pn >= 8 && pn <= 12) { const bool isk = pn == 12; heads(acc, isk ? K : Q, isk ? 256 : 1024, isk ? wc : 4 * (pn - 8) + wc, isk ? gk : gq, isk ? 1.0f : ATT_C2, row0, fq); }
        else {
            bf16_t* base = pn < 4 ? RX : pn < 8 ? GG : pn == 13 ? V : pn < 18 ? SR : SA;
            const int ldc = pn == 13 ? 256 : 1024, ct = pn < 4 ? pn : pn < 8 ? pn - 4 : pn == 13 ? 0 : pn < 18 ? pn - 14 : pn - 18;
            if (pn < 4 || pn == 13) ew<0>(acc, base, ldc, row0, ct * 256 + cpos);
            else if (pn < 8) ew<1>(acc, base, ldc, row0, ct * 256 + cpos);
            else ew<2>(acc, base, ldc, row0, ct * 256 + cpos);
        }
    }
};

struct EpiMerge {
    static constexpr bool PERM = true, AFTER_DRAIN = false;
    const bf16_t *SR, *SA; bf16_t* MG;
    __device__ __forceinline__ bool keep(const Unit& u) const { return u.z == 0; }
    __device__ __forceinline__ void operator()(f32x4 (&acc)[2][2][4][2], const Unit& u, int wr, int wc, int fr, int fq) const {
        const int row0 = u.pm * BM + wr * 64 + fr, col0 = u.pn * BM + wc * 32 + 8 * fq;
#pragma unroll
        for (int ai = 0; ai < 2; ++ai)
#pragma unroll
            for (int m = 0; m < 4; ++m)
#pragma unroll
                for (int bj = 0; bj < 2; ++bj) {
                    const size_t off = (size_t)(row0 + ai * HALF + m * 16) * 1024 + col0 + bj * HALF;
                    const u32x4 wa = *(const u32x4*)(SA + off);
                    float sa[8] = {bf_lo(wa.x), bf_hi(wa.x), bf_lo(wa.y), bf_hi(wa.y), bf_lo(wa.z), bf_hi(wa.z), bf_lo(wa.w), bf_hi(wa.w)};
#pragma unroll
                    for (int j = 0; j < 8; ++j) sa[j] = fmaxf(sa[j], 1e-30f);
                    if (u.z == 0) {
                        const u32x4 ws = *(const u32x4*)(SR + off);
                        const float sr[8] = {bf_lo(ws.x), bf_hi(ws.x), bf_lo(ws.y), bf_hi(ws.y), bf_lo(ws.z), bf_hi(ws.z), bf_lo(ws.w), bf_hi(ws.w)};
#pragma unroll
                        for (int j = 0; j < 4; ++j) { acc[ai][bj][m][0][j] *= sr[j] * __builtin_amdgcn_rcpf(sa[j]); acc[ai][bj][m][1][j] *= sr[4 + j] * __builtin_amdgcn_rcpf(sa[4 + j]); }
                    } else {
                        f32x4 v0 = acc[ai][bj][m][0], v1 = acc[ai][bj][m][1];
#pragma unroll
                        for (int j = 0; j < 4; ++j) { v0[j] *= sa[j]; v1[j] *= sa[4 + j]; }
                        *(u32x4*)(MG + off) = pack8(v0, v1);
                    }
                }
    }
};

struct EpiX1 {
    static constexpr bool PERM = false, AFTER_DRAIN = false;
    const float* x; float* out; bf16_t* X1B; float* SSQ;
    __device__ __forceinline__ bool keep(const Unit&) const { return false; }
    __device__ __forceinline__ void operator()(f32x4 (&acc)[2][2][4][2], const Unit& u, int wr, int wc, int fr, int fq) const {
        const int row0 = u.pm * BM + wr * 64 + fr, col0 = u.pn * BM + wc * 32 + 4 * fq;
#pragma unroll
        for (int ai = 0; ai < 2; ++ai)
#pragma unroll
            for (int m = 0; m < 4; ++m) { const int row = row0 + ai * HALF + m * 16; float s = 0.f;
#pragma unroll
                for (int bj = 0; bj < 2; ++bj)
#pragma unroll
                    for (int n = 0; n < 2; ++n) { const size_t off = (size_t)row * 1024 + col0 + bj * HALF + n * 16;
                        const f32x4 o = *(const f32x4*)(x + off) + acc[ai][bj][m][n]; *(f32x4*)(out + off) = o;
                        s += (o[0] * o[0] + o[1] * o[1]) + (o[2] * o[2] + o[3] * o[3]);
                        u32x2 w; w.x = cvt_pk_bf16(o[0], o[1]); w.y = cvt_pk_bf16(o[2], o[3]); *(u32x2*)(X1B + off) = w; }
                s += __shfl_xor(s, 16); s += __shfl_xor(s, 32);
                if (fq == 0) SSQ[(size_t)row * 16 + u.pn * 4 + wc] = s; }
    }
};

struct EpiFfn {
    static constexpr bool PERM = true, AFTER_DRAIN = false;
    const float* SSQ; bf16_t* F;
    __device__ __forceinline__ bool keep(const Unit&) const { return false; }
    __device__ __forceinline__ void operator()(f32x4 (&acc)[2][2][4][2], const Unit& u, int wr, int wc, int fr, int fq) const {
        const int row0 = u.pm * BM + wr * 64 + fr, colf = u.pn * HALF + wc * 32 + 8 * fq;
#pragma unroll
        for (int ai = 0; ai < 2; ++ai)
#pragma unroll
            for (int m = 0; m < 4; ++m) { const int row = row0 + ai * HALF + m * 16;
                const f32x4* sp = (const f32x4*)(SSQ + (size_t)row * 16);
                const f32x4 s0 = sp[0], s1 = sp[1], s2 = sp[2], s3 = sp[3];
                const float tot = (((s0[0] + s0[1]) + (s0[2] + s0[3])) + ((s1[0] + s1[1]) + (s1[2] + s1[3]))) + (((s2[0] + s2[1]) + (s2[2] + s2[3])) + ((s3[0] + s3[1]) + (s3[2] + s3[3])));
                const float rstd = __builtin_amdgcn_rsqf(tot * (1.0f / 1024.0f) + NORM_EPS);
                f32x4 o[2];
#pragma unroll
                for (int n = 0; n < 2; ++n) { const f32x4 a = acc[ai][0][m][n] * rstd, up = acc[ai][1][m][n] * rstd;
#pragma unroll
                    for (int j = 0; j < 4; ++j) o[n][j] = a[j] * sigmoid_f(a[j]) * up[j]; }
                *(u32x4*)(F + (size_t)row * 2816 + colf) = pack8(o[0], o[1]); }
    }
};

struct EpiOut {
    static constexpr bool PERM = false, AFTER_DRAIN = false;
    float* out;
    __device__ __forceinline__ bool keep(const Unit&) const { return false; }
    __device__ __forceinline__ void operator()(f32x4 (&acc)[2][2][4][2], const Unit& u, int wr, int wc, int fr, int fq) const {
        const int row0 = u.pm * BM + wr * 64 + fr, col0 = u.pn * BM + wc * 32 + 4 * fq;
#pragma unroll
        for (int ai = 0; ai < 2; ++ai)
#pragma unroll
            for (int m = 0; m < 4; ++m)
#pragma unroll
                for (int bj = 0; bj < 2; ++bj)
#pragma unroll
                    for (int n = 0; n < 2; ++n) { const size_t off = (size_t)(row0 + ai * HALF + m * 16) * 1024 + col0 + bj * HALF + n * 16;
                        *(f32x4*)(out + off) = *(const f32x4*)(out + off) + acc[ai][bj][m][n]; }
    }
};

template <class Epi, class Sched, bool ALIGN_EPI = false, bool SP2 = false>
__device__ __forceinline__ void gemm_phase(PG8_LAS unsigned char* lds, const Gemm g, const Sched& S, const Epi& E) {
    const int tid = threadIdx.x, wid = __builtin_amdgcn_readfirstlane(tid >> 6), lane = tid & 63, wr = wid >> 2, wc = wid & 3, fr = lane & 15, fq = lane >> 4;
    const int K = g.K, nt = K / BK;
    unsigned voffA[2], voffB[2];
#pragma unroll
    for (int i = 0; i < 2; ++i) { int R, C; stage_rc(tid * 16 + i * 8192, R, C); const int Rb = Epi::PERM ? ((R & ~31) + perm32(R & 31)) : R;
        voffA[i] = (unsigned)(R * K + C) * 2u; voffB[i] = (unsigned)(Rb * K + C) * 2u; }
    const size_t kstep = (size_t)(BK * 2);
    const size_t hstep = (size_t)HALF * K * 2;
    const size_t tstep = 2 * hstep;
    const unsigned ldsw = (unsigned)wid * 1024u;
    const int aoff = lds_byte(wr * 64 + fr, fq * 8), boff = lds_byte(wc * 32 + fr, fq * 8);
#define PG8_SA(b, h) (((b) * 2 + (h)) * HTB)
#define PG8_SB(b, h) ((4 + (b) * 2 + (h)) * HTB)
#define PG8_STAGE(bufoff, gbase, voff) do { _Pragma("unroll") for (int _i = 0; _i < 2; ++_i) \
        __builtin_amdgcn_global_load_lds((const unsigned*)((const char*)(gbase) + (voff)[_i]), (PG8_LAS unsigned*)(lds + (bufoff) + ldsw + _i * 8192), 16, 0, 0); } while (0)
#define PG8_LDA(dst, b, h) do { _Pragma("unroll") for (int m = 0; m < 4; ++m) _Pragma("unroll") for (int k = 0; k < 2; ++k) dst[m][k] = *(const PG8_LAS bf16x8*)(lds + PG8_SA(b, h) + aoff + m * 2048 + k * 1024); } while (0)
#define PG8_LDB(dst, b, h) do { _Pragma("unroll") for (int n = 0; n < 2; ++n) _Pragma("unroll") for (int k = 0; k < 2; ++k) dst[n][k] = *(const PG8_LAS bf16x8*)(lds + PG8_SB(b, h) + boff + n * 2048 + k * 1024); } while (0)
#define PG8_MMA(ai, bj, At, Bt) do { __builtin_amdgcn_s_setprio(1); _Pragma("unroll") for (int m = 0; m < 4; ++m) _Pragma("unroll") for (int n = 0; n < 2; ++n) _Pragma("unroll") for (int k = 0; k < 2; ++k) \
        acc[ai][bj][m][n] = __builtin_amdgcn_mfma_f32_16x16x32_bf16(Bt[n][k], At[m][k], acc[ai][bj][m][n], 0, 0, 0); __builtin_amdgcn_s_setprio(0); } while (0)
#define PG8_WAIT_V(n) asm volatile("s_waitcnt vmcnt(" #n ")" ::: "memory")
#define PG8_WAIT_L(n) asm volatile("s_waitcnt lgkmcnt(" #n ")" ::: "memory")
#define PG8_BAR __builtin_amdgcn_s_barrier()
#define PG8_SCHED __builtin_amdgcn_sched_barrier(0)
    Unit cur, nxt; int ui = 0;
    if (!S.next(0, cur)) return;
    f32x4 acc[2][2][4][2];
#pragma unroll
    for (int a = 0; a < 2; ++a)
#pragma unroll
        for (int b = 0; b < 2; ++b)
#pragma unroll
            for (int m = 0; m < 4; ++m)
#pragma unroll
                for (int n = 0; n < 2; ++n) acc[a][b][m][n] = (f32x4){0.f, 0.f, 0.f, 0.f};
    bf16x8 At[4][2], B0[2][2], B1[2][2];
    const char* cA = (const char*)(cur.z ? g.A1 : g.A0) + (size_t)cur.pm * tstep; const char* cB = (const char*)(cur.z ? g.B1 : g.B0) + (size_t)cur.pn * tstep;
    S.a_ready(cur);
    if constexpr (SP2) {
        PG8_STAGE(PG8_SB(0, 0), cB, voffB); PG8_STAGE(PG8_SB(0, 1), cB + hstep, voffB); PG8_STAGE(PG8_SA(0, 0), cA, voffA); PG8_STAGE(PG8_SA(0, 1), cA + hstep, voffA);
        if (wr == 1) PG8_BAR;
        PG8_WAIT_V(2); PG8_BAR;
        PG8_STAGE(PG8_SB(1, 0), cB + kstep, voffB); PG8_STAGE(PG8_SA(1, 0), cA + kstep, voffA); PG8_STAGE(PG8_SB(1, 1), cB + hstep + kstep, voffB);
        PG8_WAIT_V(6); PG8_BAR;
    } else {
        PG8_STAGE(PG8_SB(0, 0), cB, voffB); PG8_STAGE(PG8_SA(0, 0), cA, voffA); PG8_STAGE(PG8_SB(0, 1), cB + hstep, voffB); PG8_STAGE(PG8_SA(0, 1), cA + hstep, voffA);
        if (wr == 1) PG8_BAR;
        PG8_WAIT_V(4); PG8_BAR;
        PG8_STAGE(PG8_SB(1, 0), cB + kstep, voffB); PG8_STAGE(PG8_SA(1, 0), cA + kstep, voffA); PG8_STAGE(PG8_SB(1, 1), cB + hstep + kstep, voffB);
        PG8_WAIT_V(6); PG8_BAR;
    }
    for (;;) {
        const bool has_next = S.next(ui + 1, nxt);
        const char* nA = has_next ? (const char*)(nxt.z ? g.A1 : g.A0) + (size_t)nxt.pm * tstep : cA; const char* nB = has_next ? (const char*)(nxt.z ? g.B1 : g.B0) + (size_t)nxt.pn * tstep : cB;
        for (int t = 0; t < nt; t += 2) {
            const bool last = (t == nt - 2);
            const char* a1 = cA + (size_t)(t + 1) * kstep;
            const char* a2 = last ? nA : cA + (size_t)(t + 2) * kstep; const char* b2 = last ? nB : cB + (size_t)(t + 2) * kstep;
            const char* a3 = a2 + kstep; const char* b3 = b2 + kstep;
            if (last && has_next) S.a_ready(nxt);
            if constexpr (SP2) {
            PG8_LDB(B0, 0, 0); PG8_LDB(B1, 0, 1); PG8_SCHED; PG8_LDA(At, 0, 0); PG8_STAGE(PG8_SA(1, 1), a1 + hstep, voffA);
            PG8_WAIT_V(8); PG8_WAIT_L(0); PG8_BAR; PG8_MMA(0, 0, At, B0); PG8_MMA(0, 1, At, B1); PG8_BAR; PG8_SCHED;
            PG8_LDA(At, 0, 1); PG8_STAGE(PG8_SB(0, 0), b2, voffB); PG8_STAGE(PG8_SB(0, 1), b2 + hstep, voffB); PG8_STAGE(PG8_SA(0, 0), a2, voffA);
            PG8_WAIT_V(8); PG8_WAIT_L(0); PG8_BAR; PG8_MMA(1, 0, At, B0); PG8_MMA(1, 1, At, B1); PG8_BAR; PG8_SCHED;
            PG8_LDB(B0, 1, 0); PG8_LDB(B1, 1, 1); PG8_SCHED; PG8_LDA(At, 1, 0); PG8_STAGE(PG8_SA(0, 1), a2 + hstep, voffA);
            PG8_WAIT_V(8); PG8_WAIT_L(0); PG8_BAR; PG8_MMA(0, 0, At, B0); PG8_MMA(0, 1, At, B1); PG8_BAR; PG8_SCHED;
            PG8_LDA(At, 1, 1); PG8_STAGE(PG8_SB(1, 0), b3, voffB); PG8_STAGE(PG8_SB(1, 1), b3 + hstep, voffB); PG8_STAGE(PG8_SA(1, 0), a3, voffA);
            PG8_WAIT_V(8); PG8_WAIT_L(0); PG8_BAR; PG8_MMA(1, 0, At, B0); PG8_MMA(1, 1, At, B1); PG8_BAR; PG8_SCHED;
            } else {
            PG8_LDB(B0, 0, 0); PG8_SCHED; PG8_LDA(At, 0, 0); PG8_STAGE(PG8_SA(1, 1), a1 + hstep, voffA);
            PG8_WAIT_L(8); PG8_BAR; PG8_WAIT_L(0); PG8_MMA(0, 0, At, B0); PG8_BAR; PG8_SCHED;
            PG8_LDB(B1, 0, 1); PG8_STAGE(PG8_SB(0, 0), b2, voffB);
            PG8_BAR; PG8_WAIT_L(0); PG8_MMA(0, 1, At, B1); PG8_BAR;
            PG8_LDA(At, 0, 1); PG8_STAGE(PG8_SA(0, 0), a2, voffA);
            PG8_BAR; PG8_WAIT_L(0); PG8_MMA(1, 0, At, B0); PG8_BAR; PG8_SCHED;
            PG8_STAGE(PG8_SB(0, 1), b2 + hstep, voffB);
            PG8_WAIT_V(6); PG8_BAR; PG8_MMA(1, 1, At, B1); PG8_BAR;
            PG8_LDB(B0, 1, 0); PG8_SCHED; PG8_LDA(At, 1, 0); PG8_STAGE(PG8_SA(0, 1), a2 + hstep, voffA);
            PG8_WAIT_L(8); PG8_BAR; PG8_WAIT_L(0); PG8_MMA(0, 0, At, B0); PG8_BAR; PG8_SCHED;
            PG8_LDB(B1, 1, 1); PG8_STAGE(PG8_SB(1, 0), b3, voffB);
            PG8_BAR; PG8_WAIT_L(0); PG8_MMA(0, 1, At, B1); PG8_BAR;
            PG8_LDA(At, 1, 1); PG8_STAGE(PG8_SA(1, 0), a3, voffA);
            PG8_BAR; PG8_WAIT_L(0); PG8_MMA(1, 0, At, B0); PG8_BAR; PG8_SCHED;
            PG8_STAGE(PG8_SB(1, 1), b3 + hstep, voffB);
            PG8_WAIT_V(6); PG8_BAR; PG8_MMA(1, 1, At, B1); PG8_BAR;
            }
        }
        if constexpr (ALIGN_EPI) { if (wr == 0) PG8_BAR; }
        if constexpr (!Epi::AFTER_DRAIN) { E(acc, cur, wr, wc, fr, fq); S.done(cur); }
        if (!has_next) break;
        if (!E.keep(cur)) {
#pragma unroll
        for (int a = 0; a < 2; ++a)
#pragma unroll
            for (int b = 0; b < 2; ++b)
#pragma unroll
                for (int m = 0; m < 4; ++m)
#pragma unroll
                    for (int n = 0; n < 2; ++n) acc[a][b][m][n] = (f32x4){0.f, 0.f, 0.f, 0.f};
        }
        cur = nxt; cA = nA; cB = nB; ++ui;
        if constexpr (ALIGN_EPI) { if (wr == 1) PG8_BAR; }
    }
    PG8_WAIT_V(0);
    if constexpr (!ALIGN_EPI) { if (wr == 0) PG8_BAR; }
    PG8_BAR;
    if constexpr (Epi::AFTER_DRAIN) { E.fused(acc, cur, wr, wc, fr, fq, lds, wid, lane); S.done(cur); }
#undef PG8_SA
#undef PG8_SB
#undef PG8_STAGE
#undef PG8_LDA
#undef PG8_LDB
#undef PG8_MMA
#undef PG8_WAIT_V
#undef PG8_WAIT_L
#undef PG8_BAR
#undef PG8_SCHED
}
}

#include <hip/hip_bf16.h>
namespace attn_body {

using bf16=__hip_bfloat16;
using bf16x8=__attribute__((ext_vector_type(8)))short;
using s16x4=__attribute__((ext_vector_type(4)))short;
using f32x16=__attribute__((ext_vector_type(16)))float;
using u32x4=__attribute__((ext_vector_type(4)))unsigned;
constexpr int BATCH=8,NHEAD=16,SEQ=4096,D=64,DM=NHEAD*D,KVP=256;
constexpr int NW=8,QBLK=32,QB=QBLK*NW,KVBLK=64,NQB=SEQ/QB;
constexpr int ATTN_PITCH=DM, ATTN_UNIT_ROWS=QB;
__device__ __forceinline__ int crow(int r,int hi){return (r&3)+8*(r>>2)+4*hi;}
#define SBAR() __builtin_amdgcn_sched_barrier(0)
__device__ __forceinline__ void cmask(f32x16&p0,f32x16&p1,int jb,int qrel,int hi){
  const float NEG=-INFINITY; int kb=64*jb+4*hi;
  #pragma unroll
  for(int r=0;r<16;++r){int kv=kb+(r&3)+8*(r>>2); if(kv>qrel)p0[r]=NEG; if(kv+32>qrel)p1[r]=NEG;}
}

constexpr int NSLOT=3, SLOTB=8192;
constexpr int LDS_K=0, LDS_V=NSLOT*SLOTB, LDS_WS=2*NSLOT*SLOTB, LDS_OST=LDS_WS+NW*64*4, LDS_BYTES=LDS_OST+NW*4096;
constexpr float C2=0.125f*1.4426950408889634f;
__device__ __forceinline__ void glds16(const void*gsrc,unsigned lds_dst){unsigned keep;
  asm volatile("s_mov_b32 %0, m0\n\ts_mov_b32 m0, %2\n\ts_nop 0\n\tglobal_load_lds_dwordx4 %1, off\n\ts_mov_b32 m0, %0":"=&s"(keep):"v"(gsrc),"s"(lds_dst):"memory");}
__device__ __forceinline__ float max3f(float a,float b,float c){float r;asm("v_max3_f32 %0, %1, %2, %3":"=v"(r):"v"(a),"v"(b),"v"(c));return r;}
__device__ __forceinline__ float max2f(float a,float b){float r;asm("v_max_f32_e32 %0, %1, %2":"=v"(r):"v"(a),"v"(b));return r;}
__device__ __forceinline__ float fadd_s(float a,float b){float r;asm("v_add_f32_e32 %0, %1, %2":"=v"(r):"v"(a),"v"(b));return r;}
__device__ __forceinline__ float fsub_s(float a,float b){float r;asm("v_sub_f32_e32 %0, %1, %2":"=v"(r):"v"(a),"v"(b));return r;}
typedef float f32x2_t __attribute__((ext_vector_type(2))); typedef __bf16 bf16x2_t __attribute__((ext_vector_type(2)));
__device__ __forceinline__ unsigned cvtpk_s(float lo,float hi){f32x2_t v={lo,hi};bf16x2_t b=__builtin_convertvector(v,bf16x2_t);return __builtin_bit_cast(unsigned,b);}
#define WAIT_BAR(N) asm volatile("s_waitcnt vmcnt(" #N ") lgkmcnt(0)\n\ts_barrier":::"memory")

__device__ __forceinline__ void qkt(f32x16&p0,f32x16&p1,const char*Kslot,const bf16x8*qr,const f32x16&negm,int r32,int hi){
  const char*kb=Kslot+hi*1024+r32*16;
  #pragma unroll
  for(int d0=0;d0<4;++d0){
    const bf16x8 b0=*reinterpret_cast<const bf16x8*>(kb+d0*2048);
    const bf16x8 b1=*reinterpret_cast<const bf16x8*>(kb+d0*2048+512);
    if(d0==0){p0=__builtin_amdgcn_mfma_f32_32x32x16_bf16(b0,qr[0],negm,0,0,0);p1=__builtin_amdgcn_mfma_f32_32x32x16_bf16(b1,qr[0],negm,0,0,0);}
    else{p0=__builtin_amdgcn_mfma_f32_32x32x16_bf16(b0,qr[d0],p0,0,0,0);p1=__builtin_amdgcn_mfma_f32_32x32x16_bf16(b1,qr[d0],p1,0,0,0);}}
}
typedef __attribute__((address_space(3))) const char* lds_cptr;
typedef short v4i16_t __attribute__((ext_vector_type(4)));
__device__ __forceinline__ void kload8(bf16x8*kf,lds_cptr kp){
  kf[0]=*(const __attribute__((address_space(3))) bf16x8*)(kp);      kf[1]=*(const __attribute__((address_space(3))) bf16x8*)(kp+512);
  kf[2]=*(const __attribute__((address_space(3))) bf16x8*)(kp+2048); kf[3]=*(const __attribute__((address_space(3))) bf16x8*)(kp+2560);
  kf[4]=*(const __attribute__((address_space(3))) bf16x8*)(kp+4096); kf[5]=*(const __attribute__((address_space(3))) bf16x8*)(kp+4608);
  kf[6]=*(const __attribute__((address_space(3))) bf16x8*)(kp+6144); kf[7]=*(const __attribute__((address_space(3))) bf16x8*)(kp+6656);
}
__device__ __forceinline__ void kload2(bf16x8*kf,lds_cptr kp,int j){ kf[2*j]=*(const __attribute__((address_space(3))) bf16x8*)(kp+j*2048); kf[2*j+1]=*(const __attribute__((address_space(3))) bf16x8*)(kp+j*2048+512); }
__device__ __forceinline__ s16x4 vtr(lds_cptr p){ return __builtin_bit_cast(s16x4,__builtin_amdgcn_ds_read_tr16_b64_v4i16((__attribute__((address_space(3))) v4i16_t*)p)); }
__device__ __forceinline__ float rowmax(const f32x16&p0,const f32x16&p1){
  float a=max3f(p0[0],p0[1],p1[0]),b=max3f(p0[2],p0[3],p1[1]);a=max3f(a,p1[2],p1[3]);
  #pragma unroll
  for(int r=4;r<16;r+=4){a=max3f(a,p0[r],p0[r+1]);b=max3f(b,p0[r+2],p0[r+3]);a=max3f(a,p1[r],p1[r+1]);b=max3f(b,p1[r+2],p1[r+3]);}
  const float m=max2f(a,b);
  auto rr=__builtin_amdgcn_permlane32_swap(__float_as_uint(m),__float_as_uint(m),false,false);
  return max2f(__uint_as_float(rr[0]),__uint_as_float(rr[1]));
}
__device__ __forceinline__ void pv(f32x16*o,int vb,bf16x8 pa0,bf16x8 pa1,bf16x8 pa2,bf16x8 pa3){
  #pragma unroll
  for(int d0=0;d0<2;++d0){s16x4 lo[4],hi[4];
    #pragma unroll
    for(int ks=0;ks<4;++ks){
      asm volatile("ds_read_b64_tr_b16 %0,%1 offset:%c2":"=&v"(lo[ks]):"v"(vb),"i"(d0*4096+ks*1024):"memory");
      asm volatile("ds_read_b64_tr_b16 %0,%1 offset:%c2":"=&v"(hi[ks]):"v"(vb),"i"(d0*4096+ks*1024+512):"memory");}
    asm volatile("s_waitcnt lgkmcnt(0)":::"memory");SBAR();
    #define PK(k) (bf16x8){lo[k][0],lo[k][1],lo[k][2],lo[k][3],hi[k][0],hi[k][1],hi[k][2],hi[k][3]}
    o[d0]=__builtin_amdgcn_mfma_f32_32x32x16_bf16(pa0,PK(0),o[d0],0,0,0);
    o[d0]=__builtin_amdgcn_mfma_f32_32x32x16_bf16(pa1,PK(1),o[d0],0,0,0);
    o[d0]=__builtin_amdgcn_mfma_f32_32x32x16_bf16(pa2,PK(2),o[d0],0,0,0);
    o[d0]=__builtin_amdgcn_mfma_f32_32x32x16_bf16(pa3,PK(3),o[d0],0,0,0);
    #undef PK
  }
}

#ifndef ATTN_STORE16
#define ATTN_STORE16(p,v) (*(u32x4*)(p)=(v))
#endif
template<int THRL> __device__ __forceinline__ void attn_unit(int b,int h,int qb,const bf16*Q,const bf16*__restrict__ K,const bf16*__restrict__ V,bf16*O,char*shm){
  const int tid=threadIdx.x,lane=tid&63,r32=lane&31,hi=lane>>5; const int wid=__builtin_amdgcn_readfirstlane(tid>>6);
  const long rowbase=(long)b*SEQ; const int q0=qb*QB;
  const bf16*Qw=Q+(rowbase+q0+wid*QBLK)*DM+h*D;
  const bf16*Kh=K+rowbase*KVP+(h>>2)*D,*Vh=V+rowbase*KVP+(h>>2)*D;
  const unsigned lds0=(unsigned)(uintptr_t)shm;
  float*wsf=(float*)(shm+LDS_WS)+wid*64;
  const bf16*ksrc=Kh+(long)lane*KVP+wid*8;
  const bf16*vsrc=Vh+(long)(16*(wid&3)+(lane>>2))*KVP+(wid>>2)*32+(lane&3)*8;
  const unsigned kdst=lds0+LDS_K+wid*1024, vdst=lds0+LDS_V+wid*1024;
  #define DMA_K(t,slot) glds16(ksrc+(long)(t)*KVBLK*KVP,(unsigned)__builtin_amdgcn_readfirstlane(kdst+(slot)))
  #define DMA_V(t,slot) glds16(vsrc+(long)(t)*KVBLK*KVP,(unsigned)__builtin_amdgcn_readfirstlane(vdst+(slot)))
  const int vb0=(int)(lds0+LDS_V)+((lane>>4)&1)*32+(lane&3)*8+(4*hi+((lane&15)>>2))*64;
  const char*Kbase=shm+LDS_K; bf16x8 kf[8];
  const lds_cptr shm3=(lds_cptr)shm; const lds_cptr kp0=shm3+LDS_K+hi*1024+r32*16; const lds_cptr vp0=shm3+LDS_V+((lane>>4)&1)*32+(lane&3)*8+(4*hi+((lane&15)>>2))*64;
  const int NT=SEQ/KVBLK;
  DMA_K(0,0);DMA_V(0,0);DMA_K(1,SLOTB);
  bf16x8 qr[4];
  #pragma unroll
  for(int d0=0;d0<4;++d0)qr[d0]=*reinterpret_cast<const bf16x8*>(&Qw[(long)r32*DM+d0*16+hi*8]);
  float mhat=0.f,l_reg=0.f;f32x16 o[2];o[0]=f32x16{};o[1]=f32x16{};f32x16 negm=f32x16{};asm volatile("":"+v"(negm));

  #define CMASK(P0,P1,t) do{}while(0)
  bool resc=false;
  #define START(P0,P1) do{ const float rm=rowmax(P0,P1); resc=false; \
    { const float dl=rm; mhat=fadd_s(mhat,dl); \
      _Pragma("unroll") for(int r=0;r<16;++r){P0[r]=fsub_s(P0[r],dl);P1[r]=fsub_s(P1[r],dl);} \
      _Pragma("unroll") for(int r=0;r<16;++r)negm[r]=-mhat; asm volatile("":"+v"(negm)); } \
    _Pragma("unroll") for(int r=0;r<16;++r)P0[r]=__builtin_amdgcn_exp2f(P0[r]); }while(0)
  #define RESC() do{ if(resc){ asm volatile("s_waitcnt lgkmcnt(0)":::"memory"); \
      _Pragma("unroll") for(int d_=0;d_<2;++d_) _Pragma("unroll") for(int r=0;r<16;++r)o[d_][r]*=wsf[crow(r,hi)]; } }while(0)
  f32x16 pA0,pA1,pB0,pB1;
  int sl_prev=0,sl_cur=0,sl_next=SLOTB;
  #define ROT() do{sl_prev=sl_cur;sl_cur=sl_next;sl_next=(sl_next==(NSLOT-1)*SLOTB)?0:sl_next+SLOTB;}while(0)
  DMA_K(2,2*SLOTB);
  WAIT_BAR(3);
  qkt(pA0,pA1,Kbase,qr,negm,r32,hi);asm volatile("s_nop 15\n\ts_nop 7":"+v"(pA0),"+v"(pA1));CMASK(pA0,pA1,0);
  START(pA0,pA1);
  _Pragma("unroll") for(int r=0;r<16;++r)pA1[r]=__builtin_amdgcn_exp2f(pA1[r]);
  WAIT_BAR(0);
  DMA_K(3,0);DMA_V(1,SLOTB);
  ROT();
  kload8(kf,kp0+sl_cur);
  WAIT_BAR(2);
  s16x4 vlo[8],vhi[8]; u32x4 pw0,pw1,pw2,pw3;
  #define PKW(P,B) cvtpk_s(P[B],P[B+1])
  #define PAF(k) __builtin_bit_cast(bf16x8,pw##k)
  #define VFR(i) (bf16x8){vlo[i][0],vlo[i][1],vlo[i][2],vlo[i][3],vhi[i][0],vhi[i][1],vhi[i][2],vhi[i][3]}
  #define PIN(x) asm volatile("":"+v"(x))
  #define MX3(a,b,c) __builtin_fmaxf(__builtin_fmaxf((a),(b)),(c))
  #define GAPA(MF,A0,A1,A2,A3,W0,W1,PW) do{ MF; sacc+=A0; sacc+=A1; sacc+=A2; sacc+=A3; PIN(sacc); W0; W1; PIN(PW); SBAR(); }while(0)
  #define EX(v) __builtin_amdgcn_exp2f(v)
  #define GAPB(MF,X,B) do{ MF; X[B]=EX(X[B]); X[B+1]=EX(X[B+1]); X[B+2]=EX(X[B+2]); X[B+3]=EX(X[B+3]); PIN(X); SBAR(); }while(0)
  #define VRD(i) do{ vlo[i]=vtr(vp_+(((i)>>2)*4096+((i)&3)*1024)); vhi[i]=vtr(vp_+(((i)>>2)*4096+((i)&3)*1024+512)); }while(0)
  #define KRD(G,j) do{ if(G){ kload2(kf,kp0+sl_next,j); SBAR(); } }while(0)
  #define STEP(C0,C1,P0,P1,t,GK,GV,GL) do{ SBAR(); \
    const lds_cptr vp_=vp0+sl_prev; \
    VRD(0); SBAR(); float sacc=(P0[0]+P0[1]); \
    GAPA(C0=__builtin_amdgcn_mfma_f32_32x32x16_bf16(kf[0],qr[0],negm,0,0,0), P0[2],P0[3],P0[4],P0[5],     pw0[0]=PKW(P0,0), pw0[1]=PKW(P0,2), pw0); \
    VRD(4); SBAR(); GAPA(C1=__builtin_amdgcn_mfma_f32_32x32x16_bf16(kf[1],qr[0],negm,0,0,0), P0[6],P0[7],P0[8],P0[9],     pw0[2]=PKW(P0,4), pw0[3]=PKW(P0,6), pw0); \
    VRD(1); SBAR(); GAPA(C0=__builtin_amdgcn_mfma_f32_32x32x16_bf16(kf[2],qr[1],C0,0,0,0),   P0[10],P0[11],P0[12],P0[13], pw1[0]=PKW(P0,8), pw1[1]=PKW(P0,10), pw1); \
    VRD(5); SBAR(); GAPA(C1=__builtin_amdgcn_mfma_f32_32x32x16_bf16(kf[3],qr[1],C1,0,0,0),   P0[14],P0[15],P1[0],P1[1],   pw1[2]=PKW(P0,12),pw1[3]=PKW(P0,14), pw1); \
    VRD(2); SBAR(); GAPA(C0=__builtin_amdgcn_mfma_f32_32x32x16_bf16(kf[4],qr[2],C0,0,0,0),   P1[2],P1[3],P1[4],P1[5],     pw2[0]=PKW(P1,0), pw2[1]=PKW(P1,2), pw2); \
    VRD(6); SBAR(); GAPA(C1=__builtin_amdgcn_mfma_f32_32x32x16_bf16(kf[5],qr[2],C1,0,0,0),   P1[6],P1[7],P1[8],P1[9],     pw2[2]=PKW(P1,4), pw2[3]=PKW(P1,6), pw2); \
    VRD(3); SBAR(); GAPA(C0=__builtin_amdgcn_mfma_f32_32x32x16_bf16(kf[6],qr[3],C0,0,0,0),   P1[10],P1[11],P1[12],P1[13], pw3[0]=PKW(P1,8), pw3[1]=PKW(P1,10), pw3); \
    VRD(7); SBAR(); GAPA(C1=__builtin_amdgcn_mfma_f32_32x32x16_bf16(kf[7],qr[3],C1,0,0,0),   P1[14],P1[15],0.f,0.f,       pw3[2]=PKW(P1,12),pw3[3]=PKW(P1,14), pw3); \
    l_reg+=sacc; \
    if(GK){DMA_K((t)+3,sl_cur);} if(GV){DMA_V((t)+1,sl_next);} \
    CMASK(C0,C1,t); \
    { float a=MX3(C0[0],C0[1],C1[0]),b=MX3(C0[2],C0[3],C1[1]); a=MX3(a,C1[2],C1[3]); \
      _Pragma("unroll") for(int r=4;r<16;r+=4){a=MX3(a,C0[r],C0[r+1]);b=MX3(b,C0[r+2],C0[r+3]);a=MX3(a,C1[r],C1[r+1]);b=MX3(b,C1[r+2],C1[r+3]);} \
      float rm=__builtin_fmaxf(a,b); { auto rr=__builtin_amdgcn_permlane32_swap(__float_as_uint(rm),__float_as_uint(rm),false,false); rm=__builtin_fmaxf(__uint_as_float(rr[0]),__uint_as_float(rr[1])); } \
      resc=false; \
      if(__builtin_expect(__any(rm>(float)THRL),0)){ const float dl=__builtin_fmaxf(rm,0.f); mhat+=dl; \
        _Pragma("unroll") for(int r=0;r<16;++r){C0[r]-=dl;C1[r]-=dl;} \
        _Pragma("unroll") for(int r=0;r<16;++r)negm[r]=-mhat; asm volatile("":"+v"(negm)); \
        const float f=__builtin_amdgcn_exp2f(-dl); l_reg*=f; if(hi==0)wsf[r32]=f; resc=true; } } \
    SBAR(); \
    GAPB(o[0]=__builtin_amdgcn_mfma_f32_32x32x16_bf16(PAF(0),VFR(0),o[0],0,0,0), C0,0); \
    GAPB(o[1]=__builtin_amdgcn_mfma_f32_32x32x16_bf16(PAF(0),VFR(4),o[1],0,0,0), C0,4); \
    KRD(GL,0); GAPB(o[0]=__builtin_amdgcn_mfma_f32_32x32x16_bf16(PAF(1),VFR(1),o[0],0,0,0), C0,8); \
    KRD(GL,1); GAPB(o[1]=__builtin_amdgcn_mfma_f32_32x32x16_bf16(PAF(1),VFR(5),o[1],0,0,0), C0,12); \
    KRD(GL,2); GAPB(o[0]=__builtin_amdgcn_mfma_f32_32x32x16_bf16(PAF(2),VFR(2),o[0],0,0,0), C1,0); \
    KRD(GL,3); GAPB(o[1]=__builtin_amdgcn_mfma_f32_32x32x16_bf16(PAF(2),VFR(6),o[1],0,0,0), C1,4); \
    GAPB(o[0]=__builtin_amdgcn_mfma_f32_32x32x16_bf16(PAF(3),VFR(3),o[0],0,0,0), C1,8); \
    GAPB(o[1]=__builtin_amdgcn_mfma_f32_32x32x16_bf16(PAF(3),VFR(7),o[1],0,0,0), C1,12); \
    }while(0)
  int t=1;
  #undef CMASK
  #define CMASK(P0,P1,t) do{}while(0)
  for(;t+5<NT;t+=2){
    STEP(pB0,pB1,pA0,pA1,t,true,true,true);     WAIT_BAR(2); RESC(); ROT();
    STEP(pA0,pA1,pB0,pB1,t+1,true,true,true);   WAIT_BAR(2); RESC(); ROT();
  }
  #undef CMASK
  #define CMASK(P0,P1,t) do{}while(0)
  #define ENDW(tt) do{ if((tt)+3<NT){WAIT_BAR(2);} else if((tt)+2<NT){WAIT_BAR(1);} else {WAIT_BAR(0);} }while(0)
  for(;t+1<NT;t+=2){
    STEP(pB0,pB1,pA0,pA1,t,(t+3<NT),(t+1<NT),(t+1<NT));       ENDW(t);   RESC(); ROT();
    STEP(pA0,pA1,pB0,pB1,t+1,(t+4<NT),(t+2<NT),(t+2<NT));     ENDW(t+1); RESC(); ROT();
  }
  STEP(pB0,pB1,pA0,pA1,NT-1,false,false,false); RESC();
  { float sacc=pB0[0]+pB0[1]; _Pragma("unroll") for(int r=2;r<16;++r)sacc+=pB0[r]; _Pragma("unroll") for(int r=0;r<16;++r)sacc+=pB1[r]; l_reg+=sacc;
    pw0=(u32x4){PKW(pB0,0),PKW(pB0,2),PKW(pB0,4),PKW(pB0,6)};pw1=(u32x4){PKW(pB0,8),PKW(pB0,10),PKW(pB0,12),PKW(pB0,14)};pw2=(u32x4){PKW(pB1,0),PKW(pB1,2),PKW(pB1,4),PKW(pB1,6)};pw3=(u32x4){PKW(pB1,8),PKW(pB1,10),PKW(pB1,12),PKW(pB1,14)};
    SBAR(); pv(o,vb0+sl_cur,PAF(0),PAF(1),PAF(2),PAF(3)); }
  #undef PKW
  #undef PAF
  #undef VFR
  #undef PIN
  #undef MX3
  #undef GAPA
  #undef GAPB
  #undef EX
  #undef VRD
  #undef KRD
  #undef STEP
  #undef ENDW
  {auto rr=__builtin_amdgcn_permlane32_swap(__float_as_uint(l_reg),__float_as_uint(l_reg),false,false);l_reg=__uint_as_float(rr[0])+__uint_as_float(rr[1]);}
  if(hi==0)wsf[32+r32]=l_reg;asm volatile("s_waitcnt lgkmcnt(0)":::"memory");
  float rli[16];
  #pragma unroll
  for(int r=0;r<16;++r)rli[r]=__builtin_amdgcn_rcpf(wsf[32+crow(r,hi)]);
  bf16*Ow=O+(rowbase+q0+wid*QBLK)*DM+h*D;
  { bf16*stg=(bf16*)(shm+LDS_OST)+wid*2048;
    #pragma unroll
    for(int r=0;r<16;++r){const int orow=crow(r,hi);
      #pragma unroll
      for(int d0=0;d0<2;++d0)stg[orow*64+d0*32+r32]=__float2bfloat16(o[d0][r]*rli[r]);}
    asm volatile("s_waitcnt lgkmcnt(0)":::"memory");
    #pragma unroll
    for(int i=0;i<4;++i){const int row=i*8+(lane>>3),ch=lane&7; const u32x4 v=*(const u32x4*)(stg+row*64+ch*8); ATTN_STORE16(Ow+(long)row*DM+ch*8,v);} }
  asm volatile("s_waitcnt lgkmcnt(0)\n\ts_barrier":::"memory");
  #undef DMA_K
  #undef DMA_V
  #undef CMASK
  #undef START
  #undef RESC
  #undef ROT
}
constexpr int ATTN_LDS_BYTES=LDS_BYTES;
struct AttnOrder { int vcu, G;
  __device__ __forceinline__ bool next(int i,int&b,int&h,int&qb)const{
    int g,u;
    if(G==256){ if(i>=8)return false; g=4*(vcu>>5)+(i>>1); u=2*(vcu&31)+(i&1); }
    else { const int L=i*G+vcu; if(L>=2048)return false; g=L>>6; u=L&63; }
    b=g>>2; h=(g&3)*4+(u>>4); qb=u&15; return true; }
};
#undef SBAR
#undef WAIT_BAR
}

#ifndef DBG_SKIP
#define DBG_SKIP 0
#endif
constexpr int NWAVES = 8;
constexpr int N_LAUNCHES = MK_N_LAUNCHES;
constexpr int PER_PHASE = 7;
static_assert(N_LAUNCHES == 1 || N_LAUNCHES == PER_PHASE, "MK_N_LAUNCHES is 1 or 7");

constexpr int BATCH = 8, SEQ = 4096, D = 1024, M = BATCH * SEQ, DIN = 5632, DFF = 2816;
constexpr float LOG2E = 1.4426950408889634f;

constexpr size_t MiB = 1u << 20;
constexpr size_t WS_CTL = 0, CTL_ZERO_BYTES = 64 * 1024;
constexpr size_t WS_ROPE = 1 * MiB;
constexpr size_t WS_WIN = 2 * MiB, WS_WPR = 13 * MiB, WS_WPA = 15 * MiB, WS_WO = 17 * MiB, WS_WFI = 19 * MiB, WS_WFO = 30 * MiB;
constexpr size_t WS_SSQ = 36 * MiB;
constexpr size_t WS_U = 48 * MiB;
constexpr size_t WS_RX = 112 * MiB;
constexpr size_t WS_GG = 176 * MiB;
constexpr size_t WS_Q = 240 * MiB;
constexpr size_t WS_K = 304 * MiB, WS_V = 320 * MiB;
constexpr size_t WS_SR = 336 * MiB, WS_SA = 400 * MiB;
constexpr size_t WS_F = 176 * MiB;
constexpr size_t WS_END = 464 * MiB;
static_assert(WS_WFO + (size_t)D * DFF * 2 <= WS_SSQ && WS_SSQ + (size_t)M * 16 * 4 <= WS_U && WS_F + (size_t)M * DFF * 2 <= WS_SA, "d_ws map");
constexpr int CW_BAR = 1024;

constexpr int RING_OFF = 0, RING_BYTES = 131072;
constexpr int LDSCTL_OFF = RING_BYTES, MISC_OFF = LDSCTL_OFF + 320;
constexpr int LDS_BYTES = 147456;
static_assert(MISC_OFF + 128 <= LDS_BYTES, "LDS map");

#define GAS __attribute__((address_space(1)))
#define LAS __attribute__((address_space(3)))
typedef unsigned short bf16;
typedef unsigned v4u __attribute__((ext_vector_type(4)));
typedef float f32x4 __attribute__((ext_vector_type(4)));
typedef short bf16x8 __attribute__((ext_vector_type(8)));
typedef GAS unsigned gu32;
typedef GAS unsigned long long gu64;
#define RLX_AGENT __ATOMIC_RELAXED, __HIP_MEMORY_SCOPE_AGENT
#define LDS_WAIT() asm volatile("s_waitcnt lgkmcnt(0)" ::: "memory")
#define VM_WAIT() asm volatile("s_waitcnt vmcnt(0)" ::: "memory")
__device__ __forceinline__ unsigned long long rt() { return __builtin_amdgcn_s_memrealtime(); }
__device__ __forceinline__ unsigned f2bf(float f) { unsigned u = __builtin_bit_cast(unsigned, f); return (u + 0x7fffu + ((u >> 16) & 1u)) >> 16; }
__device__ __forceinline__ unsigned pk2(float lo, float hi) { return f2bf(lo) | (f2bf(hi) << 16); }

#define XB_TMO      128
#define XB_XCNT(j)  (256  + 64 * (j))
#define XB_XSUB(j)  (1280 + 64 * (j))
#define XB_XGEN(j)  (2304 + 64 * (j))
#define XB_TOP      3328
#define XB_TOPGEN   3392
#define XCD_BAR_WORDS 3456
#define XB_SPIN_CAP (1u << 18)

__device__ __forceinline__ unsigned xb_ld(unsigned* p)              { return __hip_atomic_load(p, __ATOMIC_RELAXED, __HIP_MEMORY_SCOPE_AGENT); }
__device__ __forceinline__ unsigned xb_add(unsigned* p, unsigned v) { return __hip_atomic_fetch_add(p, v, __ATOMIC_RELAXED, __HIP_MEMORY_SCOPE_AGENT); }
__device__ __forceinline__ unsigned xb_xcc_id() { return (unsigned)__builtin_amdgcn_s_getreg((3 << 11) | 20) & 0xFu; }
#define XB_SPIN(cond, bar) do { unsigned _sp = 0; while (cond) { __builtin_amdgcn_s_sleep(1); \
    if ((++_sp & 255u) == 0u) { if (xb_ld(&(bar)[XB_TMO])) break; if (_sp > XB_SPIN_CAP) { atomicAdd(&(bar)[XB_TMO], 1u); break; } } } } while (0)

struct XcdBarrier {
    unsigned* bar; unsigned x;
    volatile LAS unsigned* st;
};

__device__ __forceinline__ XcdBarrier xcd_barrier_post(unsigned* bar, volatile LAS unsigned* st) {
    XcdBarrier b; b.bar = bar; b.x = xb_xcc_id(); b.st = st;
    if (threadIdx.x == 0) (void)xb_add(&bar[XB_XCNT(b.x)], 1u);
    return b;
}
__device__ __forceinline__ void xcd_barrier_complete(unsigned* bar, unsigned x, unsigned& nloc, unsigned& nx) {
    const unsigned G = gridDim.x * gridDim.y * gridDim.z;
    unsigned sum, cnt, mine, sp = 0u;
    for (;;) {
        sum = 0u; cnt = 0u; mine = 0u;
#pragma unroll
        for (unsigned j = 0; j < 16; ++j) { const unsigned c = xb_ld(&bar[XB_XCNT(j)]); sum += c; cnt += (c > 0u) ? 1u : 0u; mine = (j == x) ? c : mine; }
        if (sum == G) break;
        __builtin_amdgcn_s_sleep(1);
        if ((++sp & 255u) == 0u) { if (xb_ld(&bar[XB_TMO])) break; if (sp > XB_SPIN_CAP) { atomicAdd(&bar[XB_TMO], 1u); break; } }
    }
    nloc = mine > 0u ? mine : 1u; nx = cnt > 0u ? cnt : 1u;
}

__device__ __forceinline__ void xcd_barrier(const XcdBarrier& b) {
    asm volatile("s_waitcnt vmcnt(0)" ::: "memory");
    __syncthreads();
    if (threadIdx.x == 0) {
        unsigned* bar = b.bar;
        __builtin_amdgcn_s_waitcnt(0);
        unsigned nloc = b.st[0], nx = b.st[1];
        if (nloc == 0u) { xcd_barrier_complete(bar, b.x, nloc, nx); b.st[0] = nloc; b.st[1] = nx; }
        const unsigned old = xb_add(&bar[XB_XSUB(b.x)], 1u);
        const unsigned gen = old / nloc;
        if (old + 1u == (gen + 1u) * nloc) {
            __builtin_amdgcn_fence(__ATOMIC_RELEASE, "agent");
            asm volatile("s_waitcnt vmcnt(0)" ::: "memory");
            const unsigned og = xb_add(&bar[XB_TOP], 1u);
            const unsigned tg = og / nx;
            if (og + 1u == (tg + 1u) * nx) xb_add(&bar[XB_TOPGEN], 1u);
            else XB_SPIN(xb_ld(&bar[XB_TOPGEN]) == tg, bar);
            __builtin_amdgcn_fence(__ATOMIC_ACQUIRE, "agent");
            xb_add(&bar[XB_XGEN(b.x)], 1u);
            asm volatile("s_waitcnt vmcnt(0)" ::: "memory");
        } else {
            XB_SPIN(xb_ld(&bar[XB_XGEN(b.x)]) == gen, bar);
            __builtin_amdgcn_fence(__ATOMIC_ACQUIRE, "agent");
            asm volatile("s_waitcnt vmcnt(0)" ::: "memory");
        }
    }
    __syncthreads();
}


using pg8::bf_lo; using pg8::bf_hi; using pg8::sigmoid_f;
struct Frame {
    LAS unsigned char* lds;
    volatile LAS unsigned* MISC;
    gu32* ctl;
    int tid, lane, wave;
    int vcu, G;
    const float* x; float* out;
    const float *norm1_g, *w_in, *conv_w, *conv_b, *wa_f, *ba_f, *wx_f, *bx_f, *lam_f, *wa_b, *ba_b, *wx_b, *bx_b, *lam_b, *q_norm_g, *k_norm_g, *p_rnn, *p_attn, *w_o, *norm2_g, *w_ffn_in, *w_ffn_out;
    bf16 *Win_t, *Wpr_t, *Wpa_t, *Wo_t, *Wfi_t, *Wfo_t;
    bf16 *U, *RX, *GG, *Q, *K, *V, *SR, *SA, *MG, *X1B, *Fb;
    float *ROPE, *SSQ;
};

__device__ __forceinline__ float wave_sum(float v) {
#pragma unroll
    for (int o = 1; o < 64; o <<= 1) v += __shfl_xor(v, o);
    return v;
}
__device__ __forceinline__ void p0_transpose_item(const float* W, int K, int N, bf16* WT, int src_col0, int dst_row0, int k0, const float* kscale, LAS float* scr, int lane) {
#pragma unroll 8
    for (int i = 0; i < 32; ++i) { const int kk = 2 * i + (lane >> 5); float v = W[(size_t)(k0 + kk) * N + src_col0 + (lane & 31)]; if (kscale) v *= kscale[k0 + kk]; scr[kk * 33 + (lane & 31)] = v; }
    LDS_WAIT(); asm volatile("" ::: "memory");
    const int c = lane & 7;
#pragma unroll
    for (int j = 0; j < 4; ++j) { const int n = (lane >> 3) + 8 * j; const LAS float* s = scr + (8 * c) * 33 + n;
        v4u o; o.x = pk2(s[0 * 33], s[1 * 33]); o.y = pk2(s[2 * 33], s[3 * 33]); o.z = pk2(s[4 * 33], s[5 * 33]); o.w = pk2(s[6 * 33], s[7 * 33]);
        *(GAS v4u*)(WT + (size_t)(dst_row0 + n) * K + k0 + 8 * c) = o; }
    LDS_WAIT(); asm volatile("" ::: "memory");
}
__device__ __forceinline__ void rms_row_to_bf16(Frame& F, const float* xrow, const float* g, bf16* orow) {
    const GAS f32x4* xr = (const GAS f32x4*)xrow + F.lane; const GAS f32x4* gr = (const GAS f32x4*)g + F.lane;
    f32x4 v[4]; float s = 0.f;
#pragma unroll
    for (int j = 0; j < 4; ++j) { v[j] = xr[64 * j]; s += (v[j].x * v[j].x + v[j].y * v[j].y) + (v[j].z * v[j].z + v[j].w * v[j].w); }
    const float rstd = 1.f / sqrtf(wave_sum(s) * (1.f / D) + 1e-6f);
    GAS unsigned long long* o8 = (GAS unsigned long long*)orow + F.lane;
#pragma unroll
    for (int j = 0; j < 4; ++j) { const f32x4 gg = gr[64 * j]; o8[64 * j] = (unsigned long long)pk2(v[j].x * rstd * gg.x, v[j].y * rstd * gg.y) | ((unsigned long long)pk2(v[j].z * rstd * gg.z, v[j].w * rstd * gg.w) << 32); }
}
__device__ __forceinline__ void p0_prologue(Frame& F) {
    LAS float* scr = (LAS float*)(F.lds + RING_OFF + F.wave * 16384);
    const int gw = F.vcu * NWAVES + F.wave, NGW = F.G * NWAVES;
    constexpr int I_IN = (D / 64) * (DIN / 32), I_SQ = (D / 64) * (D / 32), I_FI = I_IN, I_FO = (DFF / 64) * (D / 32);
    constexpr int NITEMS = I_IN + 3 * I_SQ + I_FI + I_FO;
    for (int it = gw; it < NITEMS; it += NGW) {
        int r = it;
        if (r < I_IN) { const int kb = r / (DIN / 32), n0 = 32 * (r % (DIN / 32)), tile = n0 >> 8, p = n0 & 255;
            const int src = (tile >= 8 && tile <= 12) ? tile * 256 + 64 * ((p >> 5) & 3) + 32 * (p >> 7) : n0;
            p0_transpose_item(F.w_in, D, DIN, F.Win_t, src, n0, 64 * kb, nullptr, scr, F.lane); continue; } r -= I_IN;
        if (r < I_SQ) { p0_transpose_item(F.p_rnn, D, D, F.Wpr_t, 32 * (r % 32), 32 * (r % 32), 64 * (r / 32), nullptr, scr, F.lane); continue; } r -= I_SQ;
        if (r < I_SQ) { p0_transpose_item(F.p_attn, D, D, F.Wpa_t, 32 * (r % 32), 32 * (r % 32), 64 * (r / 32), nullptr, scr, F.lane); continue; } r -= I_SQ;
        if (r < I_SQ) { p0_transpose_item(F.w_o, D, D, F.Wo_t, 32 * (r % 32), 32 * (r % 32), 64 * (r / 32), nullptr, scr, F.lane); continue; } r -= I_SQ;
        if (r < I_FI) { const int kb = r / (DIN / 32), n0 = 32 * (r % (DIN / 32)), pn = n0 >> 8, p = n0 & 255;
            const int src = (p >> 7) * DFF + 128 * pn + (p & 127);
            p0_transpose_item(F.w_ffn_in, D, DIN, F.Wfi_t, src, n0, 64 * kb, F.norm2_g, scr, F.lane); continue; } r -= I_FI;
        p0_transpose_item(F.w_ffn_out, DFF, D, F.Wfo_t, 32 * (r % 32), 32 * (r % 32), 64 * (r / 32), nullptr, scr, F.lane);
    }
    for (int m = gw; m < M; m += NGW) rms_row_to_bf16(F, F.x + (size_t)m * D, F.norm1_g, F.U + (size_t)m * D);
    const int gt = F.vcu * (NWAVES * 64) + F.tid;
    if (gt < 1024) { const int pos = gt >> 4, i = gt & 15; double inv = 1.0; for (int k = 0; k < i; ++k) inv *= 0.5623413251903491;
        const double ang = (double)pos * inv, q = __builtin_rint(ang * 0.6366197723675814);
        double r = __builtin_fma(-q, 1.5707963267948966, ang); r = __builtin_fma(-q, 6.123233995736766e-17, r);
        const double r2 = r * r;
        double sn = 1.0 / 1307674368000.0; sn = sn * r2 - 1.0 / 6227020800.0; sn = sn * r2 + 1.0 / 39916800.0; sn = sn * r2 - 1.0 / 362880.0; sn = sn * r2 + 1.0 / 5040.0; sn = sn * r2 - 1.0 / 120.0; sn = sn * r2 + 1.0 / 6.0; sn = -sn * r2 + 1.0; sn *= r;
        double cs = 1.0 / 20922789888000.0; cs = cs * r2 - 1.0 / 87178291200.0; cs = cs * r2 + 1.0 / 479001600.0; cs = cs * r2 - 1.0 / 3628800.0; cs = cs * r2 + 1.0 / 40320.0; cs = cs * r2 - 1.0 / 720.0; cs = cs * r2 + 1.0 / 24.0; cs = cs * r2 - 0.5; cs = cs * r2 + 1.0;
        const int qi = (int)q & 3; const double c = qi == 0 ? cs : qi == 1 ? -sn : qi == 2 ? -cs : sn, s = qi == 0 ? sn : qi == 1 ? cs : qi == 2 ? -sn : -cs;
        F.ROPE[gt * 2] = (float)c; F.ROPE[gt * 2 + 1] = (float)s; }
}

typedef float f32x16 __attribute__((ext_vector_type(16)));
constexpr int SC_ROWB = 144, SC_TILE = 0, SC_CW = 40960, SC_WAB = 43008;
__device__ __forceinline__ int crow16(int r, int hi) { return (r & 3) + 8 * (r >> 2) + 4 * hi; }
template <int DIR> __device__ __forceinline__ void scan_sweep(Frame& F, int b, int blk, int half) {
    const int lane = F.lane, w = F.wave, n = lane & 31, hi = lane >> 5, tid = F.tid;
    const int c = blk * 64 + half * 32 + n;
    LAS unsigned char* lds = F.lds;
    const float* wa = (DIR ? F.wa_b : F.wa_f) + blk * 4096; const float* wx = (DIR ? F.wx_b : F.wx_f) + blk * 4096;
    bf16x8 bfr[4], bfi[4];
#pragma unroll
    for (int s = 0; s < 4; ++s)
#pragma unroll
        for (int j = 0; j < 8; ++j) { const int k = 16 * s + 8 * hi + j; bfr[s][j] = (short)f2bf(wa[k * 64 + half * 32 + n]); bfi[s][j] = (short)f2bf(wx[k * 64 + half * 32 + n]); }
    const float bias_r = (DIR ? F.ba_b : F.ba_f)[c], bias_i = (DIR ? F.bx_b : F.bx_f)[c];
    float k8;
    { const float lam = (DIR ? F.lam_b : F.lam_f)[c]; const float e = __builtin_amdgcn_exp2f(-fabsf(lam) * LOG2E);
      const float l1p = e < 0.05f ? e * (1.0f + e * (-0.5f + e * (0.33333333f + e * (-0.25f + e * (0.2f + e * (-0.16666667f)))))) : __logf(1.0f + e);
      k8 = 8.0f * (fmaxf(-lam, 0.0f) + l1p); }
    const float cw0 = F.conv_w[c], cw1 = F.conv_w[1024 + c], cw2 = F.conv_w[2048 + c], cw3 = F.conv_w[3072 + c], cb = F.conv_b[c];
    const LAS float* CWT = (const LAS float*)(lds + SC_CW);
    LAS float* WAB = (LAS float*)(lds + SC_WAB);
    float carry = 0.f;
    for (int ck = 0; ck < 16; ++ck) {
        const int cc = DIR ? 15 - ck : ck, t0 = cc * 256;
        for (int p = tid; p < 260 * 8; p += NWAVES * 64) { const int rr = p >> 3, q = p & 7, t = t0 - 2 + rr;
            v4u v = {0u, 0u, 0u, 0u}; if (t >= 0 && t < SEQ) v = *(const GAS v4u*)(F.RX + (size_t)(b * SEQ + t) * D + blk * 64 + q * 8);
            *(LAS v4u*)(lds + SC_TILE + rr * SC_ROWB + q * 16) = v; }
        __syncthreads();
        f32x16 rp, ip;
#pragma unroll
        for (int q = 0; q < 16; ++q) { rp[q] = 0.f; ip[q] = 0.f; }
        const int rbase = 32 * w + n;
#pragma unroll
        for (int s = 0; s < 4; ++s) {
            const int ch0 = 16 * s + 8 * hi;
            const f32x4 b0 = *(const LAS f32x4*)(CWT + 256 + ch0), b1 = *(const LAS f32x4*)(CWT + 256 + ch0 + 4);
            float a8[8] = {b0[0], b0[1], b0[2], b0[3], b1[0], b1[1], b1[2], b1[3]};
#pragma unroll
            for (int k = 0; k < 4; ++k) {
                const v4u xv = *(const LAS v4u*)(lds + SC_TILE + (rbase + k) * SC_ROWB + ch0 * 2);
                const f32x4 w0 = *(const LAS f32x4*)(CWT + k * 64 + ch0), w1 = *(const LAS f32x4*)(CWT + k * 64 + ch0 + 4);
                a8[0] += bf_lo(xv.x) * w0[0]; a8[1] += bf_hi(xv.x) * w0[1]; a8[2] += bf_lo(xv.y) * w0[2]; a8[3] += bf_hi(xv.y) * w0[3];
                a8[4] += bf_lo(xv.z) * w1[0]; a8[5] += bf_hi(xv.z) * w1[1]; a8[6] += bf_lo(xv.w) * w1[2]; a8[7] += bf_hi(xv.w) * w1[3];
            }
            v4u ap; ap.x = pk2(a8[0], a8[1]); ap.y = pk2(a8[2], a8[3]); ap.z = pk2(a8[4], a8[5]); ap.w = pk2(a8[6], a8[7]);
            const bf16x8 afr = __builtin_bit_cast(bf16x8, ap);
            rp = __builtin_amdgcn_mfma_f32_32x32x16_bf16(afr, bfr[s], rp, 0, 0, 0);
            ip = __builtin_amdgcn_mfma_f32_32x32x16_bf16(afr, bfi[s], ip, 0, 0, 0);
        }
        float A[16], Bv[16];
#pragma unroll
        for (int g = 0; g < 4; ++g) {
            float xv[7];
#pragma unroll
            for (int i = 0; i < 7; ++i) xv[i] = __uint_as_float((unsigned)*(const LAS unsigned short*)(lds + SC_TILE + (32 * w + 8 * g + 4 * hi + i) * SC_ROWB + (half * 32 + n) * 2) << 16);
#pragma unroll
            for (int j = 0; j < 4; ++j) { const int q = 4 * g + j;
                const float xo = cb + cw0 * xv[j] + cw1 * xv[j + 1] + cw2 * xv[j + 2] + cw3 * xv[j + 3];
                const float r = sigmoid_f(rp[q] + bias_r), ig = sigmoid_f(ip[q] + bias_i);
                const float la = -k8 * r, y = 2.0f * la;
                A[q] = __builtin_amdgcn_exp2f(la * LOG2E);
                const float em = -y * (1.0f + y * 0.5f * (1.0f + y * 0.33333333f * (1.0f + y * 0.25f * (1.0f + y * 0.2f * (1.0f + y * 0.16666667f * (1.0f + y * 0.14285714f))))));
                Bv[q] = __builtin_amdgcn_sqrtf(fmaxf(em, 0.f)) * ig * xo; }
        }
        float loA[4], loB[4], hiA[4], hiB[4];
#pragma unroll
        for (int g = 0; g < 4; ++g) {
            if (DIR == 0) {
#pragma unroll
                for (int j = 1; j < 4; ++j) { const int q = 4 * g + j; Bv[q] = A[q] * Bv[q - 1] + Bv[q]; A[q] *= A[q - 1]; }
            } else {
#pragma unroll
                for (int j = 2; j >= 0; --j) { const int q = 4 * g + j; Bv[q] = A[q] * Bv[q + 1] + Bv[q]; A[q] *= A[q + 1]; }
            }
            const float sA = A[4 * g + (DIR ? 0 : 3)], sB = Bv[4 * g + (DIR ? 0 : 3)];
            const auto ra = __builtin_amdgcn_permlane32_swap(__float_as_uint(sA), __float_as_uint(sA), false, false);
            const auto rb = __builtin_amdgcn_permlane32_swap(__float_as_uint(sB), __float_as_uint(sB), false, false);
            loA[g] = __uint_as_float(ra[0]); hiA[g] = __uint_as_float(ra[1]); loB[g] = __uint_as_float(rb[0]); hiB[g] = __uint_as_float(rb[1]);
        }
        float WA = 1.f, WB = 0.f;
        if (DIR == 0) {
#pragma unroll
            for (int g = 0; g < 4; ++g) { WB = loA[g] * WB + loB[g]; WA *= loA[g]; WB = hiA[g] * WB + hiB[g]; WA *= hiA[g]; }
        } else {
#pragma unroll
            for (int g = 3; g >= 0; --g) { WB = hiA[g] * WB + hiB[g]; WA *= hiA[g]; WB = loA[g] * WB + loB[g]; WA *= loA[g]; }
        }
        if (hi == 0) { WAB[(w * 32 + n) * 2] = WA; WAB[(w * 32 + n) * 2 + 1] = WB; }
        __syncthreads();
        float x = carry, cinw = 0.f;
#pragma unroll
        for (int i = 0; i < 8; ++i) { const int ww = DIR ? 7 - i : i; const float a = WAB[(ww * 32 + n) * 2], bq = WAB[(ww * 32 + n) * 2 + 1]; if (ww == w) cinw = x; x = a * x + bq; }
        carry = x;
        x = cinw;
        float hv[16];
        if (DIR == 0) {
#pragma unroll
            for (int g = 0; g < 4; ++g) { const float x0 = x, x1 = loA[g] * x0 + loB[g], cin = hi ? x1 : x0; x = hiA[g] * x1 + hiB[g];
#pragma unroll
                for (int j = 0; j < 4; ++j) hv[4 * g + j] = Bv[4 * g + j] + A[4 * g + j] * cin; }
        } else {
#pragma unroll
            for (int g = 3; g >= 0; --g) { const float x0 = x, x1 = hiA[g] * x0 + hiB[g], cin = hi ? x0 : x1; x = loA[g] * x1 + loB[g];
#pragma unroll
                for (int j = 0; j < 4; ++j) hv[4 * g + j] = Bv[4 * g + j] + A[4 * g + j] * cin; }
        }
#pragma unroll
        for (int q = 0; q < 16; ++q) { const size_t idx = (size_t)(b * SEQ + t0 + 32 * w + crow16(q, hi)) * D + c;
            if (DIR == 0) F.out[idx] = hv[q];
            else { const float hs = F.out[idx] + hv[q]; const float gg = __uint_as_float((unsigned)F.GG[idx] << 16); F.GG[idx] = (bf16)f2bf(hs * gg); } }
    }
}
__device__ __forceinline__ void scan_item(Frame& F, int item) {
    const int b = item >> 5, blk = (item >> 1) & 15, half = item & 1;
    LAS float* CWT = (LAS float*)(F.lds + SC_CW);
    if (F.tid < 256) CWT[F.tid] = F.conv_w[(F.tid >> 6) * 1024 + blk * 64 + (F.tid & 63)];
    else if (F.tid < 320) CWT[F.tid] = F.conv_b[blk * 64 + (F.tid - 256)];
    __syncthreads();
    scan_sweep<0>(F, b, blk, half);
    scan_sweep<1>(F, b, blk, half);
    __syncthreads();
}

struct Args { const float* in[23]; float* out; unsigned char* ws; int ph_lo, ph_hi, li, pad; };
__global__ void __launch_bounds__(NWAVES * 64, 2) skel_fwd(Args args) {
    extern __shared__ __attribute__((aligned(16))) unsigned char lds[];
    Frame F;
    F.lds = (LAS unsigned char*)lds;
    F.MISC = (volatile LAS unsigned*)(F.lds + MISC_OFF);
    F.tid = threadIdx.x; F.lane = F.tid & 63; F.wave = __builtin_amdgcn_readfirstlane(F.tid >> 6);
    F.G = gridDim.x; { const int bx = blockIdx.x; F.vcu = (F.G % 8 == 0) ? (bx % 8) * (F.G / 8) + bx / 8 : bx; }
    unsigned char* ws = args.ws;
    F.ctl = (gu32*)(ws + WS_CTL);
    F.x = args.in[0]; F.norm1_g = args.in[1]; F.w_in = args.in[2]; F.conv_w = args.in[3]; F.conv_b = args.in[4]; F.wa_f = args.in[5]; F.ba_f = args.in[6]; F.wx_f = args.in[7]; F.bx_f = args.in[8]; F.lam_f = args.in[9];
    F.wa_b = args.in[10]; F.ba_b = args.in[11]; F.wx_b = args.in[12]; F.bx_b = args.in[13]; F.lam_b = args.in[14]; F.q_norm_g = args.in[15]; F.k_norm_g = args.in[16]; F.p_rnn = args.in[17]; F.p_attn = args.in[18];
    F.w_o = args.in[19]; F.norm2_g = args.in[20]; F.w_ffn_in = args.in[21]; F.w_ffn_out = args.in[22]; F.out = args.out;
    F.Win_t = (bf16*)(ws + WS_WIN); F.Wpr_t = (bf16*)(ws + WS_WPR); F.Wpa_t = (bf16*)(ws + WS_WPA); F.Wo_t = (bf16*)(ws + WS_WO); F.Wfi_t = (bf16*)(ws + WS_WFI); F.Wfo_t = (bf16*)(ws + WS_WFO);
    F.U = (bf16*)(ws + WS_U); F.RX = (bf16*)(ws + WS_RX); F.GG = (bf16*)(ws + WS_GG); F.Q = (bf16*)(ws + WS_Q); F.K = (bf16*)(ws + WS_K); F.V = (bf16*)(ws + WS_V);
    F.SR = (bf16*)(ws + WS_SR); F.SA = (bf16*)(ws + WS_SA); F.MG = (bf16*)(ws + WS_U); F.X1B = (bf16*)(ws + WS_RX); F.Fb = (bf16*)(ws + WS_F);
    F.ROPE = (float*)(ws + WS_ROPE); F.SSQ = (float*)(ws + WS_SSQ);
    for (int u = F.tid; u < (LDS_BYTES - LDSCTL_OFF) / 4; u += NWAVES * 64) ((LAS unsigned*)(F.lds + LDSCTL_OFF))[u] = 0u;
    __syncthreads();
    XcdBarrier bar; bar.bar = (unsigned*)(F.ctl + CW_BAR); bar.x = 0; bar.st = nullptr;
    if (N_LAUNCHES != PER_PHASE) bar = xcd_barrier_post((unsigned*)(F.ctl + CW_BAR), F.MISC + 8);
#define GRID_BAR() do { if (N_LAUNCHES != PER_PHASE) xcd_barrier(bar); } while (0)
    const int lo = args.ph_lo, hi = args.ph_hi;
#define IN(k) (lo <= (k) && (k) < hi)
#define BOTH(k) (IN(k) && IN((k) + 1))

    if (IN(0) && !(DBG_SKIP & 1)) { p0_prologue(F); if (BOTH(0)) GRID_BAR(); }

    if (IN(1) && !(DBG_SKIP & 2)) {
        pg8::Gemm g{F.U, F.U, F.Win_t, F.Win_t, M, DIN, D}; pg8::StaticOrder S; S.init(M, DIN, F.G, (int)blockIdx.x);
        pg8::EpiProj E{F.RX, F.GG, F.Q, F.K, F.V, F.SR, F.SA, F.q_norm_g, F.k_norm_g, F.ROPE};
        pg8::gemm_phase<pg8::EpiProj, pg8::StaticOrder, true, true>(F.lds + RING_OFF, g, S, E);
        if (BOTH(1)) GRID_BAR();
    }

    if (IN(2) && !(DBG_SKIP & 4)) {
        for (int it = F.vcu; it < 256; it += F.G) scan_item(F, it);
        const attn_body::AttnOrder S{F.vcu, F.G};
        int b, h, qb;
        for (int i = 0; S.next(i, b, h, qb); ++i)
            attn_body::attn_unit<8>(b, h, qb, (const attn_body::bf16*)F.Q, (const attn_body::bf16*)F.K, (const attn_body::bf16*)F.V, (attn_body::bf16*)F.Q, (char*)lds + RING_OFF);
        if (BOTH(2)) GRID_BAR();
    }

    if (IN(3) && !(DBG_SKIP & 8)) {
        pg8::Gemm g{F.GG, F.Q, F.Wpr_t, F.Wpa_t, M, D, D}; pg8::PairOrder S; S.init(M, D, F.G, (int)blockIdx.x);
        pg8::EpiMerge E{F.SR, F.SA, F.MG};
        pg8::gemm_phase<pg8::EpiMerge, pg8::PairOrder, true, true>(F.lds + RING_OFF, g, S, E);
        if (BOTH(3)) GRID_BAR();
    }

    if (IN(4) && !(DBG_SKIP & 16)) {
        pg8::Gemm g{F.MG, F.MG, F.Wo_t, F.Wo_t, M, D, D}; pg8::StaticOrder S; S.init(M, D, F.G, (int)blockIdx.x);
        pg8::EpiX1 E{F.x, F.out, F.X1B, F.SSQ};
        pg8::gemm_phase<pg8::EpiX1, pg8::StaticOrder, true, true>(F.lds + RING_OFF, g, S, E);
        if (BOTH(4)) GRID_BAR();
    }

    if (IN(5) && !(DBG_SKIP & 32)) {
        pg8::Gemm g{F.X1B, F.X1B, F.Wfi_t, F.Wfi_t, M, DIN, D}; pg8::StaticOrder S; S.init(M, DIN, F.G, (int)blockIdx.x);
        pg8::EpiFfn E{F.SSQ, F.Fb};
        pg8::gemm_phase<pg8::EpiFfn, pg8::StaticOrder, true, true>(F.lds + RING_OFF, g, S, E);
        if (BOTH(5)) GRID_BAR();
    }

    if (IN(6) && !(DBG_SKIP & 64)) {
        pg8::Gemm g{F.Fb, F.Fb, F.Wfo_t, F.Wfo_t, M, D, DFF}; pg8::StaticOrder S; S.init(M, D, F.G, (int)blockIdx.x);
        pg8::EpiOut E{F.out};
        pg8::gemm_phase<pg8::EpiOut, pg8::StaticOrder, true, true>(F.lds + RING_OFF, g, S, E);
    }
#undef IN
#undef BOTH
}


#ifndef DBG_STOP
#define DBG_STOP 0
#endif
#if DBG_STOP
__global__ void dbg_dump(float* out, const unsigned char* ws, int stop) {
    const size_t i = (size_t)blockIdx.x * blockDim.x + threadIdx.x;
    const size_t row = i >> 10, col = i & 1023;
    auto bf = [](const unsigned char* p, size_t idx) { return __uint_as_float((unsigned)((const unsigned short*)p)[idx] << 16); };
    float v = 0.f;
    if (stop == 1) { v = bf(ws + WS_U, i) + 3.f * bf(ws + WS_WIN, i) + 5.f * bf(ws + WS_WFI, i) + 7.f * bf(ws + WS_WPR, i & 1048575) + 11.f * bf(ws + WS_WPA, i & 1048575) + 13.f * bf(ws + WS_WO, i & 1048575) + 17.f * bf(ws + WS_WFO, i % (1024 * 2816)) + ((const float*)(ws + WS_ROPE))[i & 2047]; }
    if (stop == 2) { v = bf(ws + WS_Q, i) + 3.f * bf(ws + WS_GG, i) + 5.f * bf(ws + WS_RX, i) + 7.f * bf(ws + WS_SR, i) + 11.f * bf(ws + WS_SA, i); if (col < 256) v += 13.f * bf(ws + WS_K, row * 256 + col) + 17.f * bf(ws + WS_V, row * 256 + col); }
    if (stop == 3) { v = bf(ws + WS_Q, i) + 3.f * bf(ws + WS_GG, i); }
    if (stop == 31) { v = bf(ws + WS_Q, i); }
    if (stop == 32) { v = bf(ws + WS_GG, i); }
    if (stop == 4) { v = bf(ws + WS_U, i); }
    if (stop == 5) { v = out[i] + 3.f * bf(ws + WS_RX, i) + ((const float*)(ws + WS_SSQ))[i & (32768 * 16 - 1)]; }
    if (stop == 6) { v = bf(ws + WS_F, i) + bf(ws + WS_F, i + (size_t)32768 * 1024) + ((i + (size_t)2 * 32768 * 1024) < (size_t)32768 * 2816 ? bf(ws + WS_F, i + (size_t)2 * 32768 * 1024) : 0.f); }
    out[i] = v;
}
#endif
extern "C" void kernel_launch(void* const* d_in, const int* in_sizes, int n_in, void* d_out, int out_size, void* d_ws, size_t ws_size, hipStream_t stream) {
    static int grid = 0;
    if (grid == 0) {
        if (n_in != 23 || in_sizes[0] != M * D || out_size != M * D || ws_size < WS_END) { fprintf(stderr, "kernel_launch: unexpected shapes (n_in %d, in0 %d, out %d, ws %zu); nothing launched\n", n_in, n_in > 0 ? in_sizes[0] : -1, out_size, ws_size); grid = -1; return; }
        int dev = 0, cus = 0, per_cu = 0;
        if (hipGetDevice(&dev) != hipSuccess || hipDeviceGetAttribute(&cus, hipDeviceAttributeMultiprocessorCount, dev) != hipSuccess) { fprintf(stderr, "kernel_launch: device query failed\n"); grid = -1; return; }
        if (hipFuncSetAttribute((const void*)skel_fwd, hipFuncAttributeMaxDynamicSharedMemorySize, LDS_BYTES) != hipSuccess) { fprintf(stderr, "kernel_launch: hipFuncSetAttribute failed\n"); grid = -1; return; }
        if (hipOccupancyMaxActiveBlocksPerMultiprocessor(&per_cu, (const void*)skel_fwd, NWAVES * 64, LDS_BYTES) != hipSuccess || per_cu < 1) { fprintf(stderr, "kernel_launch: occupancy query reports %d workgroups per CU\n", per_cu); }
        (void)hipGetLastError();
        grid = cus;
    }
    if (grid < 0) return;
    if (hipMemsetAsync((char*)d_ws + WS_CTL, 0, CTL_ZERO_BYTES, stream) != hipSuccess) { fprintf(stderr, "kernel_launch: hipMemsetAsync failed\n"); return; }
    Args a{};
    for (int i = 0; i < 23; ++i) a.in[i] = (const float*)d_in[i];
    a.out = (float*)d_out; a.ws = (unsigned char*)d_ws;
    for (int li = 0; li < N_LAUNCHES; ++li) {
#if DBG_STOP
        if (li >= (DBG_STOP > 10 ? DBG_STOP / 10 : DBG_STOP)) break;
#endif
        a.ph_lo = (N_LAUNCHES == PER_PHASE) ? li : 0; a.ph_hi = (N_LAUNCHES == PER_PHASE) ? li + 1 : PER_PHASE; a.li = li;
        hipLaunchKernelGGL(skel_fwd, dim3(grid), dim3(NWAVES * 64), LDS_BYTES, stream, a);
        const hipError_t le = hipPeekAtLastError();
        if (le != hipSuccess) { fprintf(stderr, "kernel_launch: launch %d failed: %s\n", li, hipGetErrorName(le)); break; }
    }
#if DBG_STOP
    hipLaunchKernelGGL(dbg_dump, dim3(M * D / 256), dim3(256), 0, stream, (float*)d_out, (const unsigned char*)d_ws, (int)DBG_STOP);
#endif
}
```

```cpp
#include <hip/hip_runtime.h>
#include <hip/hip_bf16.h>
#include <cstdio>
#include <cstdint>
#include <cmath>

#ifndef DBG_EPI2
#define DBG_EPI2 0
#endif
#ifndef RELAX_EPI
#define RELAX_EPI 1
#endif
#ifndef WGM_BIG
#define WGM_BIG 5
#endif
#ifndef WGM_SMALL
#define WGM_SMALL 5
#endif
#ifndef MK_N_LAUNCHES
#define MK_N_LAUNCHES 1
#endif

__device__ __forceinline__ int lane_id_fresh() { int l; asm volatile("v_mbcnt_lo_u32_b32 %0, -1, 0\n\tv_mbcnt_hi_u32_b32 %0, -1, %0" : "=v"(l)); return l; }

namespace pg8 {
#define PG8_LAS __attribute__((address_space(3)))
typedef unsigned short bf16_t;
typedef short bf16x8 __attribute__((ext_vector_type(8)));
typedef float f32x4 __attribute__((ext_vector_type(4)));
typedef unsigned u32x4 __attribute__((ext_vector_type(4)));
typedef unsigned u32x2 __attribute__((ext_vector_type(2)));
constexpr int BM = 256, BK = 64, HALF = 128, HTB = HALF * BK * 2  , STAGE_BYTES = 8 * HTB, NXCD = 8;

__host__ __device__ __forceinline__ int lds_byte(int r, int c) { const int st = (r >> 4) * 2 + (c >> 5), rr = r & 15, cc = c & 31, ob = rr * 64 + cc * 2; return st * 1024 + (ob ^ (((ob >> 9) & 1) << 5)); }
__host__ __device__ __forceinline__ void stage_rc(int b, int& R, int& C) { const int st = b / 1024, sb = b % 1024, swz = sb ^ (((sb >> 9) & 1) << 5); R = (st >> 1) * 16 + swz / 64; C = (st & 1) * 32 + (swz % 64) / 2; }
__host__ __device__ __forceinline__ int perm32(int rho) { const int n = rho >> 4, i = rho & 15; return 8 * (i >> 2) + 4 * n + (i & 3); }

struct Unit { int pm, pn, z; };
struct Gemm { const bf16_t *A0, *A1, *B0, *B1; int M, N, K; };

struct StaticOrder {
    int nM, nN, nwg, G, c, wgm;
    __host__ __device__ void init(int M, int N, int G_, int c_, int wgm_) { nM = M / BM; nN = N / BM; nwg = nM * nN; G = G_; c = c_; wgm = wgm_; }
    __host__ __device__ bool next(int i, Unit& u) const {
        const long L = (long)i * G + c; if (L >= nwg) return false;
        int wgid = (int)L; { const int q = nwg / NXCD, r = nwg % NXCD, xcd = wgid % NXCD, off = wgid / NXCD; wgid = (xcd < r ? xcd * (q + 1) : r * (q + 1) + (xcd - r) * q) + off; }
        const int nig = wgm * nN, gid = wgid / nig, fm = gid * wgm, gsz = (nM - fm) < wgm ? (nM - fm) : wgm;
        u.pm = fm + ((wgid % nig) % gsz); u.pn = (wgid % nig) / gsz; u.z = 0; return true;
    }
    __device__ __forceinline__ void a_ready(const Unit&) const {}
    __device__ __forceinline__ void done(const Unit&) const {}
};
struct PairOrder : StaticOrder {
    __host__ __device__ bool next(int i, Unit& u) const { const bool ok = StaticOrder::next(i >> 1, u); u.z = i & 1; return ok; }
};

typedef float f32x2_t __attribute__((ext_vector_type(2))); typedef __bf16 bf16x2_t __attribute__((ext_vector_type(2)));
__device__ __forceinline__ unsigned cvt_pk_bf16(float lo, float hi) { f32x2_t v = {lo, hi}; bf16x2_t b = __builtin_convertvector(v, bf16x2_t); return __builtin_bit_cast(unsigned, b); }
__device__ __forceinline__ float bf_lo(unsigned w) { return __uint_as_float(w << 16); }
__device__ __forceinline__ float bf_hi(unsigned w) { return __uint_as_float(w & 0xffff0000u); }
__device__ __forceinline__ float sigmoid_f(float v) { return __builtin_amdgcn_rcpf(1.0f + __builtin_amdgcn_exp2f(-1.4426950408889634f * v)); }
__device__ __forceinline__ float gelu_tanh_f(float v) { const float u = v * (1.0f + 0.044715f * v * v); return v * __builtin_amdgcn_rcpf(1.0f + __builtin_amdgcn_exp2f(-2.302208198f * u)); }
__device__ __forceinline__ u32x4 pack8(f32x4 v0, f32x4 v1) { u32x4 w; w.x = cvt_pk_bf16(v0[0], v0[1]); w.y = cvt_pk_bf16(v0[2], v0[3]); w.z = cvt_pk_bf16(v1[0], v1[1]); w.w = cvt_pk_bf16(v1[2], v1[3]); return w; }
constexpr float NORM_EPS = 1e-6f;
constexpr float ATT_C2 = 0.125f * 1.4426950408889634f;

struct EpiProj {
    static constexpr bool PERM = true, AFTER_DRAIN = false; static constexpr int NST = 16;
    __device__ __forceinline__ bool relax_ok(const Unit&, int ui) const { return ui > 0; }
    bf16_t *RX, *GG, *Q, *K, *V, *SR, *SA; const PG8_LAS float *gq, *gk; const PG8_LAS float* rope;
    __device__ __forceinline__ bool keep(const Unit&) const { return false; }
    template <int ACT> __device__ __forceinline__ void ew(f32x4 (&acc)[2][2][4][2], bf16_t* base, int ldc, int row0, int col0) const {
#pragma unroll
        for (int ai = 0; ai < 2; ++ai)
#pragma unroll
            for (int m = 0; m < 4; ++m) { bf16_t* rowp = base + (size_t)(row0 + ai * HALF + m * 16) * ldc + col0;
#pragma unroll
                for (int bj = 0; bj < 2; ++bj) { f32x4 v0 = acc[ai][bj][m][0], v1 = acc[ai][bj][m][1];
                    if (ACT == 1) {
#pragma unroll
                        for (int j = 0; j < 4; ++j) { v0[j] = gelu_tanh_f(v0[j]); v1[j] = gelu_tanh_f(v1[j]); } }
                    if (ACT == 2) {
#pragma unroll
                        for (int j = 0; j < 4; ++j) { v0[j] = sigmoid_f(v0[j]); v1[j] = sigmoid_f(v1[j]); } }
                    *(u32x4*)(rowp + bj * HALF) = pack8(v0, v1); }
                asm volatile("" ::: "memory"); }
    }
    __device__ __forceinline__ void heads(f32x4 (&acc)[2][2][4][2], bf16_t* base, int ldc, int head, const PG8_LAS float* g, float scale, int row0, int fq) const {
        f32x4 gv[2][2];
#pragma unroll
        for (int bj = 0; bj < 2; ++bj)
#pragma unroll
            for (int n = 0; n < 2; ++n) gv[bj][n] = *(const PG8_LAS f32x4*)(g + 32 * bj + 8 * fq + 4 * n);
#pragma unroll
        for (int ai = 0; ai < 2; ++ai)
#pragma unroll
            for (int m = 0; m < 4; ++m) {
                const int row = row0 + ai * HALF + m * 16, s = row & 4095, rp = s >> 6, cp = s & 63;
                float ss = 0.f;
#pragma unroll
                for (int bj = 0; bj < 2; ++bj)
#pragma unroll
                    for (int n = 0; n < 2; ++n) { const f32x4 v = acc[ai][bj][m][n]; ss += (v[0] * v[0] + v[1] * v[1]) + (v[2] * v[2] + v[3] * v[3]); }
                ss += __shfl_xor(ss, 16); ss += __shfl_xor(ss, 32);
                const float rstd = __builtin_amdgcn_rsqf(ss * (1.0f / 64.0f) + NORM_EPS) * scale;
                bf16_t* rowp = base + (size_t)row * ldc + head * 64 + 8 * fq;
#pragma unroll
                for (int bj = 0; bj < 2; ++bj) {
                    const int pos = bj == 0 ? rp : cp;
                    const PG8_LAS f32x4* tp = (const PG8_LAS f32x4*)(rope + (pos * 16 + 4 * fq) * 2);
                    const f32x4 t0 = tp[0], t1 = tp[1];
                    f32x4 o[2];
#pragma unroll
                    for (int n = 0; n < 2; ++n) { const f32x4 v = acc[ai][bj][m][n] * gv[bj][n] * rstd; const f32x4 t = n ? t1 : t0;
                        o[n] = (f32x4){v[0] * t[0] - v[1] * t[1], v[0] * t[1] + v[1] * t[0], v[2] * t[2] - v[3] * t[3], v[2] * t[3] + v[3] * t[2]}; }
                    *(u32x4*)(rowp + 32 * bj) = pack8(o[0], o[1]); }
                asm volatile("" ::: "memory");
            }
    }
    __device__ __forceinline__ void operator()(f32x4 (&acc)[2][2][4][2], const Unit& u, int wr, int wc, int fr, int fq) const {
        const int pn = u.pn, row0 = u.pm * BM + wr * 64 + fr, cpos = wc * 32 + 8 * fq;
        if (pn >= 8 && pn <= 12) { const bool isk = pn == 12; heads(acc, isk ? K : Q, isk ? 256 : 1024, isk ? wc : 4 * (pn - 8) + wc, isk ? gk : gq, isk ? 1.0f : ATT_C2, row0, fq); }
        else {
            bf16_t* base = pn < 4 ? RX : pn < 8 ? GG : pn == 13 ? V : pn < 18 ? SR : SA;
            const int ldc = pn == 13 ? 256 : 1024, ct = pn < 4 ? pn : pn < 8 ? pn - 4 : pn == 13 ? 0 : pn < 18 ? pn - 14 : pn - 18;
            if (pn < 4 || pn == 13) ew<0>(acc, base, ldc, row0, ct * 256 + cpos);
            else if (pn < 8) ew<1>(acc, base, ldc, row0, ct * 256 + cpos);
            else ew<2>(acc, base, ldc, row0, ct * 256 + cpos);
        }
    }
};

struct EpiMerge {
    static constexpr bool PERM = true, AFTER_DRAIN = false; static constexpr int NST = 16;
    __device__ __forceinline__ bool relax_ok(const Unit& u, int ui) const { return ui > 0 && u.z == 0; }
    const bf16_t *SR, *SA; bf16_t* MG;
    __device__ __forceinline__ bool keep(const Unit& u) const { return u.z == 0; }
    __device__ __forceinline__ void operator()(f32x4 (&acc)[2][2][4][2], const Unit& u, int wr, int wc, int fr, int fq) const {
        const int row0 = u.pm * BM + wr * 64 + fr, col0 = u.pn * BM + wc * 32 + 8 * fq;
#pragma unroll
        for (int ai = 0; ai < 2; ++ai) {
            u32x4 wa[4][2], ws[4][2];
#pragma unroll
            for (int m = 0; m < 4; ++m)
#pragma unroll
                for (int bj = 0; bj < 2; ++bj) { const size_t off = (size_t)(row0 + ai * HALF + m * 16) * 1024 + col0 + bj * HALF;
                    wa[m][bj] = *(const u32x4*)(SA + off); if (u.z == 0) ws[m][bj] = *(const u32x4*)(SR + off); }
            asm volatile("" ::: "memory");
#pragma unroll
            for (int m = 0; m < 4; ++m)
#pragma unroll
                for (int bj = 0; bj < 2; ++bj) { const size_t off = (size_t)(row0 + ai * HALF + m * 16) * 1024 + col0 + bj * HALF;
                    const u32x4 a = wa[m][bj];
                    float sa[8] = {bf_lo(a.x), bf_hi(a.x), bf_lo(a.y), bf_hi(a.y), bf_lo(a.z), bf_hi(a.z), bf_lo(a.w), bf_hi(a.w)};
#pragma unroll
                    for (int j = 0; j < 8; ++j) sa[j] = fmaxf(sa[j], 1e-30f);
                    if (u.z == 0) {
                        const u32x4 s = ws[m][bj];
                        const float sr[8] = {bf_lo(s.x), bf_hi(s.x), bf_lo(s.y), bf_hi(s.y), bf_lo(s.z), bf_hi(s.z), bf_lo(s.w), bf_hi(s.w)};
#pragma unroll
                        for (int j = 0; j < 4; ++j) { acc[ai][bj][m][0][j] *= sr[j] * __builtin_amdgcn_rcpf(sa[j]); acc[ai][bj][m][1][j] *= sr[4 + j] * __builtin_amdgcn_rcpf(sa[4 + j]); }
                    } else {
                        f32x4 v0 = acc[ai][bj][m][0], v1 = acc[ai][bj][m][1];
#pragma unroll
                        for (int j = 0; j < 4; ++j) { v0[j] *= sa[j]; v1[j] *= sa[4 + j]; }
                        *(u32x4*)(MG + off) = pack8(v0, v1);
                    } }
        }
    }
};

struct EpiX1 {
    static constexpr bool PERM = false, AFTER_DRAIN = false; static constexpr int NST = 40;
    __device__ __forceinline__ bool relax_ok(const Unit&, int ui) const { return ui > 0; }
    const float* x; bf16_t* X1B; float* SSQ;
    __device__ __forceinline__ bool keep(const Unit&) const { return false; }
    __device__ __forceinline__ void ld(f32x4 (&xv)[2][2][2], int r, int row0, int col0) const {
#pragma unroll
        for (int mm = 0; mm < 2; ++mm)
#pragma unroll
            for (int bj = 0; bj < 2; ++bj)
#pragma unroll
                for (int n = 0; n < 2; ++n) xv[mm][bj][n] = *(const f32x4*)(x + (size_t)(row0 + (r >> 1) * HALF + (2 * (r & 1) + mm) * 16) * 1024 + col0 + bj * HALF + n * 16);
    }
    __device__ __forceinline__ void add(f32x4 (&acc)[2][2][4][2], const f32x4 (&xv)[2][2][2], int r) const {
#pragma unroll
        for (int mm = 0; mm < 2; ++mm)
#pragma unroll
            for (int bj = 0; bj < 2; ++bj)
#pragma unroll
                for (int n = 0; n < 2; ++n) acc[r >> 1][bj][2 * (r & 1) + mm][n] += xv[mm][bj][n];
    }
    __device__ __forceinline__ void st(const f32x4 (&acc)[2][2][4][2], int r, int row0, int col0, int pn, int wc, int fq) const {
        const int ai = r >> 1;
#pragma unroll
        for (int mm = 0; mm < 2; ++mm) { const int m = 2 * (r & 1) + mm, row = row0 + ai * HALF + m * 16; float s = 0.f;
#pragma unroll
            for (int bj = 0; bj < 2; ++bj)
#pragma unroll
                for (int n = 0; n < 2; ++n) { const f32x4 o = acc[ai][bj][m][n]; s += (o[0] * o[0] + o[1] * o[1]) + (o[2] * o[2] + o[3] * o[3]);
                    u32x2 w; w.x = cvt_pk_bf16(o[0], o[1]); w.y = cvt_pk_bf16(o[2], o[3]); *(u32x2*)(X1B + (size_t)row * 1024 + col0 + bj * HALF + n * 16) = w; }
            s += __shfl_xor(s, 16); s += __shfl_xor(s, 32);
            if (fq == 0) SSQ[(size_t)row * 16 + pn * 4 + wc] = s; }
    }
    __device__ __forceinline__ void operator()(f32x4 (&acc)[2][2][4][2], const Unit& u, int wr, int wc, int fr, int fq) const {
        const int row0 = u.pm * BM + wr * 64 + fr, col0 = u.pn * BM + wc * 32 + 4 * fq;
        f32x4 xv[2][2][2];
        ld(xv, 0, row0, col0);
#pragma unroll
        for (int r = 0; r < 4; ++r) {
            asm volatile("" ::: "memory");
            add(acc, xv, r);
            asm volatile("" ::: "memory");
            if (r < 3) ld(xv, r + 1, row0, col0);
            asm volatile("" ::: "memory");
            st(acc, r, row0, col0, u.pn, wc, fq);
        }
    }
};

struct EpiFfn {
    static constexpr bool PERM = true, AFTER_DRAIN = false; static constexpr int NST = 8;
    __device__ __forceinline__ bool relax_ok(const Unit&, int ui) const { return ui > 0; }
    const float* SSQ; bf16_t* F;
    __device__ __forceinline__ bool keep(const Unit&) const { return false; }
    __device__ __forceinline__ void operator()(f32x4 (&acc)[2][2][4][2], const Unit& u, int wr, int wc, int fr, int fq) const {
        const int row0 = u.pm * BM + wr * 64 + fr, colf = u.pn * HALF + wc * 32 + 8 * fq;
        f32x4 sp[2][4];
#pragma unroll
        for (int ai = 0; ai < 2; ++ai)
#pragma unroll
            for (int m = 0; m < 4; ++m) sp[ai][m] = *(const f32x4*)(SSQ + (size_t)(row0 + ai * HALF + m * 16) * 16 + 4 * fq);
        asm volatile("" ::: "memory");
        float rs[2][4];
#pragma unroll
        for (int ai = 0; ai < 2; ++ai)
#pragma unroll
            for (int m = 0; m < 4; ++m) { float tot = (sp[ai][m][0] + sp[ai][m][1]) + (sp[ai][m][2] + sp[ai][m][3]);
                tot += __shfl_xor(tot, 16); tot += __shfl_xor(tot, 32);
                rs[ai][m] = __builtin_amdgcn_rsqf(tot * (1.0f / 1024.0f) + NORM_EPS); }
        asm volatile("" : "+v"(rs[0][0]), "+v"(rs[0][1]), "+v"(rs[0][2]), "+v"(rs[0][3]), "+v"(rs[1][0]), "+v"(rs[1][1]), "+v"(rs[1][2]), "+v"(rs[1][3]));
#pragma unroll
        for (int ai = 0; ai < 2; ++ai)
#pragma unroll
            for (int m = 0; m < 4; ++m) { const int row = row0 + ai * HALF + m * 16;
                const float rstd = rs[ai][m];
                f32x4 o[2];
#pragma unroll
                for (int n = 0; n < 2; ++n) { const f32x4 a = acc[ai][0][m][n] * rstd, up = acc[ai][1][m][n] * rstd;
#pragma unroll
                    for (int j = 0; j < 4; ++j) o[n][j] = a[j] * sigmoid_f(a[j]) * up[j]; }
                *(u32x4*)(F + (size_t)row * 2816 + colf) = pack8(o[0], o[1]); }
    }
};

struct EpiOut {
    static constexpr bool PERM = false, AFTER_DRAIN = false; static constexpr int NST = 32;
    __device__ __forceinline__ bool relax_ok(const Unit&, int ui) const { return ui > 0; }
    const bf16_t* X1B; float* out;
    __device__ __forceinline__ bool keep(const Unit&) const { return false; }
    __device__ __forceinline__ void operator()(f32x4 (&acc)[2][2][4][2], const Unit& u, int wr, int wc, int fr, int fq) const {
        const int row0 = u.pm * BM + wr * 64 + fr, col0 = u.pn * BM + wc * 32 + 4 * fq;
        u32x2 xv[2][4][2][2];
#pragma unroll
        for (int ai = 0; ai < 2; ++ai)
#pragma unroll
            for (int m = 0; m < 4; ++m)
#pragma unroll
                for (int bj = 0; bj < 2; ++bj)
#pragma unroll
                    for (int n = 0; n < 2; ++n) xv[ai][m][bj][n] = *(const u32x2*)(X1B + (size_t)(row0 + ai * HALF + m * 16) * 1024 + col0 + bj * HALF + n * 16);
        asm volatile("" ::: "memory");
#pragma unroll
        for (int ai = 0; ai < 2; ++ai)
#pragma unroll
            for (int m = 0; m < 4; ++m)
#pragma unroll
                for (int bj = 0; bj < 2; ++bj)
#pragma unroll
                    for (int n = 0; n < 2; ++n) { const u32x2 w = xv[ai][m][bj][n];
                        *(f32x4*)(out + (size_t)(row0 + ai * HALF + m * 16) * 1024 + col0 + bj * HALF + n * 16) = (f32x4){bf_lo(w.x), bf_hi(w.x), bf_lo(w.y), bf_hi(w.y)} + acc[ai][bj][m][n]; }
    }
};

template <class Epi, class Sched, bool ALIGN_EPI = false, bool SP2 = false>
__device__ __forceinline__ void gemm_phase(PG8_LAS unsigned char* lds, const Gemm g, const Sched& S, const Epi& E, bool dbg_twice = false) {
    const int wid = __builtin_amdgcn_readfirstlane((int)threadIdx.x >> 6), lane = lane_id_fresh(), tid = wid * 64 + lane,     wr = wid >> 2, wc = wid & 3, fr = lane & 15, fq = lane >> 4;
    const int K = g.K, nt = K / BK;
    unsigned voffA[2], voffB[2];
#pragma unroll
    for (int i = 0; i < 2; ++i) { int R, C; stage_rc(tid * 16 + i * 8192, R, C); const int Rb = Epi::PERM ? ((R & ~31) + perm32(R & 31)) : R;
        voffA[i] = (unsigned)(R * K + C) * 2u; voffB[i] = (unsigned)(Rb * K + C) * 2u; }
    const size_t kstep = (size_t)(BK * 2);
    const size_t hstep = (size_t)HALF * K * 2;
    const size_t tstep = 2 * hstep;
    const unsigned ldsw = (unsigned)wid * 1024u;
    const int aoff = lds_byte(wr * 64 + fr, fq * 8), boff = lds_byte(wc * 32 + fr, fq * 8);
#define PG8_SA(b, h) (((b) * 2 + (h)) * HTB)
#define PG8_SB(b, h) ((4 + (b) * 2 + (h)) * HTB)
#define PG8_STAGE(bufoff, gbase, voff) do { _Pragma("unroll") for (int _i = 0; _i < 2; ++_i) \
        __builtin_amdgcn_global_load_lds((const unsigned*)((const char*)(gbase) + (voff)[_i]), (PG8_LAS unsigned*)(lds + (bufoff) + ldsw + _i * 8192), 16, 0, 0); } while (0)
#define PG8_LDA(dst, b, h) do { _Pragma("unroll") for (int m = 0; m < 4; ++m) _Pragma("unroll") for (int k = 0; k < 2; ++k) dst[m][k] = *(const PG8_LAS bf16x8*)(lds + PG8_SA(b, h) + aoff + m * 2048 + k * 1024); } while (0)
#define PG8_LDB(dst, b, h) do { _Pragma("unroll") for (int n = 0; n < 2; ++n) _Pragma("unroll") for (int k = 0; k < 2; ++k) dst[n][k] = *(const PG8_LAS bf16x8*)(lds + PG8_SB(b, h) + boff + n * 2048 + k * 1024); } while (0)
#define PG8_MMA(ai, bj, At, Bt) do { __builtin_amdgcn_s_setprio(1); _Pragma("unroll") for (int m = 0; m < 4; ++m) _Pragma("unroll") for (int n = 0; n < 2; ++n) _Pragma("unroll") for (int k = 0; k < 2; ++k) \
        acc[ai][bj][m][n] = __builtin_amdgcn_mfma_f32_16x16x32_bf16(Bt[n][k], At[m][k], acc[ai][bj][m][n], 0, 0, 0); __builtin_amdgcn_s_setprio(0); } while (0)
#define PG8_WAIT_V(n) asm volatile("s_waitcnt vmcnt(" #n ")" ::: "memory")
#define PG8_WAIT_L(n) asm volatile("s_waitcnt lgkmcnt(" #n ")" ::: "memory")
#define PG8_WAIT_V8R_(n) asm volatile("s_cmp_eq_u32 %0, 0\n\ts_cbranch_scc1 .Lrlxn_%=\n\ts_waitcnt vmcnt(8)\n\ts_branch .Lrlxd_%=\n.Lrlxn_%=:\n\ts_waitcnt vmcnt(" #n ")\n.Lrlxd_%=:" :: "s"(rlx) : "scc", "memory")
#define PG8_WAIT_V8R() do { if constexpr (!RELAX_EPI) PG8_WAIT_V(8); else if constexpr (Epi::NST == 8) PG8_WAIT_V8R_(16); else if constexpr (Epi::NST == 16) PG8_WAIT_V8R_(24); else if constexpr (Epi::NST == 32) PG8_WAIT_V8R_(40); else if constexpr (Epi::NST == 40) PG8_WAIT_V8R_(48); else PG8_WAIT_V(8); } while (0)
#define PG8_BAR __builtin_amdgcn_s_barrier()
#define PG8_SCHED __builtin_amdgcn_sched_barrier(0)
    Unit cur, nxt; int ui = 0;
    if (!S.next(0, cur)) return;
    f32x4 acc[2][2][4][2];
#pragma unroll
    for (int a = 0; a < 2; ++a)
#pragma unroll
        for (int b = 0; b < 2; ++b)
#pragma unroll
            for (int m = 0; m < 4; ++m)
#pragma unroll
                for (int n = 0; n < 2; ++n) acc[a][b][m][n] = (f32x4){0.f, 0.f, 0.f, 0.f};
    bf16x8 At[4][2], B0[2][2], B1[2][2];
    const char* cA = (const char*)(cur.z ? g.A1 : g.A0) + (size_t)cur.pm * tstep; const char* cB = (const char*)(cur.z ? g.B1 : g.B0) + (size_t)cur.pn * tstep;
    S.a_ready(cur);
    if constexpr (SP2) {
        PG8_STAGE(PG8_SB(0, 0), cB, voffB); PG8_STAGE(PG8_SB(0, 1), cB + hstep, voffB); PG8_STAGE(PG8_SA(0, 0), cA, voffA); PG8_STAGE(PG8_SA(0, 1), cA + hstep, voffA);
        if (wr == 1) PG8_BAR;
        PG8_WAIT_V(2); PG8_BAR;
        PG8_STAGE(PG8_SB(1, 0), cB + kstep, voffB); PG8_STAGE(PG8_SA(1, 0), cA + kstep, voffA); PG8_STAGE(PG8_SB(1, 1), cB + hstep + kstep, voffB);
        PG8_WAIT_V(6); PG8_BAR;
    } else {
        PG8_STAGE(PG8_SB(0, 0), cB, voffB); PG8_STAGE(PG8_SA(0, 0), cA, voffA); PG8_STAGE(PG8_SB(0, 1), cB + hstep, voffB); PG8_STAGE(PG8_SA(0, 1), cA + hstep, voffA);
        if (wr == 1) PG8_BAR;
        PG8_WAIT_V(4); PG8_BAR;
        PG8_STAGE(PG8_SB(1, 0), cB + kstep, voffB); PG8_STAGE(PG8_SA(1, 0), cA + kstep, voffA); PG8_STAGE(PG8_SB(1, 1), cB + hstep + kstep, voffB);
        PG8_WAIT_V(6); PG8_BAR;
    }
    for (;;) {
        const bool has_next = S.next(ui + 1, nxt);
        const char* nA = has_next ? (const char*)(nxt.z ? g.A1 : g.A0) + (size_t)nxt.pm * tstep : cA; const char* nB = has_next ? (const char*)(nxt.z ? g.B1 : g.B0) + (size_t)nxt.pn * tstep : cB;
        for (int t = 0; t < nt; t += 2) {
            const bool last = (t == nt - 2);
            const char* a1 = cA + (size_t)(t + 1) * kstep;
            const char* a2 = last ? nA : cA + (size_t)(t + 2) * kstep; const char* b2 = last ? nB : cB + (size_t)(t + 2) * kstep;
            const char* a3 = a2 + kstep; const char* b3 = b2 + kstep;
            if (last && has_next) S.a_ready(nxt);
            if constexpr (SP2) {
            const int rlx = __builtin_amdgcn_readfirstlane(t | (E.relax_ok(cur, ui) ? 0 : 1));
            PG8_LDB(B0, 0, 0); PG8_LDB(B1, 0, 1); PG8_SCHED; PG8_LDA(At, 0, 0); PG8_STAGE(PG8_SA(1, 1), a1 + hstep, voffA);
            PG8_WAIT_V8R(); PG8_WAIT_L(0); PG8_BAR; PG8_MMA(0, 0, At, B0); PG8_MMA(0, 1, At, B1); PG8_BAR; PG8_SCHED;
            PG8_LDA(At, 0, 1); PG8_STAGE(PG8_SB(0, 0), b2, voffB); PG8_STAGE(PG8_SB(0, 1), b2 + hstep, voffB); PG8_STAGE(PG8_SA(0, 0), a2, voffA);
            PG8_WAIT_V8R(); PG8_WAIT_L(0); PG8_BAR; PG8_MMA(1, 0, At, B0); PG8_MMA(1, 1, At, B1); PG8_BAR; PG8_SCHED;
            PG8_LDB(B0, 1, 0); PG8_LDB(B1, 1, 1); PG8_SCHED; PG8_LDA(At, 1, 0); PG8_STAGE(PG8_SA(0, 1), a2 + hstep, voffA);
            PG8_WAIT_V(8); PG8_WAIT_L(0); PG8_BAR; PG8_MMA(0, 0, At, B0); PG8_MMA(0, 1, At, B1); PG8_BAR; PG8_SCHED;
            PG8_LDA(At, 1, 1); PG8_STAGE(PG8_SB(1, 0), b3, voffB); PG8_STAGE(PG8_SB(1, 1), b3 + hstep, voffB); PG8_STAGE(PG8_SA(1, 0), a3, voffA);
            PG8_WAIT_V(8); PG8_WAIT_L(0); PG8_BAR; PG8_MMA(1, 0, At, B0); PG8_MMA(1, 1, At, B1); PG8_BAR; PG8_SCHED;
            } else {
            PG8_LDB(B0, 0, 0); PG8_SCHED; PG8_LDA(At, 0, 0); PG8_STAGE(PG8_SA(1, 1), a1 + hstep, voffA);
            PG8_WAIT_L(8); PG8_BAR; PG8_WAIT_L(0); PG8_MMA(0, 0, At, B0); PG8_BAR; PG8_SCHED;
            PG8_LDB(B1, 0, 1); PG8_STAGE(PG8_SB(0, 0), b2, voffB);
            PG8_BAR; PG8_WAIT_L(0); PG8_MMA(0, 1, At, B1); PG8_BAR;
            PG8_LDA(At, 0, 1); PG8_STAGE(PG8_SA(0, 0), a2, voffA);
            PG8_BAR; PG8_WAIT_L(0); PG8_MMA(1, 0, At, B0); PG8_BAR; PG8_SCHED;
            PG8_STAGE(PG8_SB(0, 1), b2 + hstep, voffB);
            PG8_WAIT_V(6); PG8_BAR; PG8_MMA(1, 1, At, B1); PG8_BAR;
            PG8_LDB(B0, 1, 0); PG8_SCHED; PG8_LDA(At, 1, 0); PG8_STAGE(PG8_SA(0, 1), a2 + hstep, voffA);
            PG8_WAIT_L(8); PG8_BAR; PG8_WAIT_L(0); PG8_MMA(0, 0, At, B0); PG8_BAR; PG8_SCHED;
            PG8_LDB(B1, 1, 1); PG8_STAGE(PG8_SB(1, 0), b3, voffB);
            PG8_BAR; PG8_WAIT_L(0); PG8_MMA(0, 1, At, B1); PG8_BAR;
            PG8_LDA(At, 1, 1); PG8_STAGE(PG8_SA(1, 0), a3, voffA);
            PG8_BAR; PG8_WAIT_L(0); PG8_MMA(1, 0, At, B0); PG8_BAR; PG8_SCHED;
            PG8_STAGE(PG8_SB(1, 1), b3 + hstep, voffB);
            PG8_WAIT_V(6); PG8_BAR; PG8_MMA(1, 1, At, B1); PG8_BAR;
            }
        }
        if constexpr (ALIGN_EPI) { if (wr == 0) PG8_BAR; }
        if constexpr (!Epi::AFTER_DRAIN) { int ln_ = lane; asm volatile("" : "+v"(ln_)); const int fr_ = ln_ & 15, fq_ = ln_ >> 4;
            E(acc, cur, wr, wc, fr_, fq_);
#if DBG_EPI2
            if (dbg_twice) { asm volatile("" ::: "memory"); E(acc, cur, wr, wc, fr_, fq_); }
#endif
            S.done(cur); }
        if (!has_next) break;
        if (!E.keep(cur)) {
#pragma unroll
        for (int a = 0; a < 2; ++a)
#pragma unroll
            for (int b = 0; b < 2; ++b)
#pragma unroll
                for (int m = 0; m < 4; ++m)
#pragma unroll
                    for (int n = 0; n < 2; ++n) acc[a][b][m][n] = (f32x4){0.f, 0.f, 0.f, 0.f};
        }
        cur = nxt; cA = nA; cB = nB; ++ui;
        if constexpr (ALIGN_EPI) { if (wr == 1) PG8_BAR; }
    }
    PG8_WAIT_V(0);
    if constexpr (!ALIGN_EPI) { if (wr == 0) PG8_BAR; }
    PG8_BAR;
    if constexpr (Epi::AFTER_DRAIN) { E.fused(acc, cur, wr, wc, fr, fq, lds, wid, lane); S.done(cur); }
#undef PG8_SA
#undef PG8_SB
#undef PG8_STAGE
#undef PG8_LDA
#undef PG8_LDB
#undef PG8_MMA
#undef PG8_WAIT_V
#undef PG8_WAIT_V8R
#undef PG8_WAIT_V8R_
#undef PG8_WAIT_L
#undef PG8_BAR
#undef PG8_SCHED
}
}

#include <hip/hip_bf16.h>
namespace attn_body {

using bf16=__hip_bfloat16;
using bf16x8=__attribute__((ext_vector_type(8)))short;
using s16x4=__attribute__((ext_vector_type(4)))short;
using f32x16=__attribute__((ext_vector_type(16)))float;
using u32x4=__attribute__((ext_vector_type(4)))unsigned;
constexpr int BATCH=8,NHEAD=16,SEQ=4096,D=64,DM=NHEAD*D,KVP=256;
constexpr int NW=8,QBLK=32,QB=QBLK*NW,KVBLK=64,NQB=SEQ/QB;
constexpr int ATTN_PITCH=DM, ATTN_UNIT_ROWS=QB;
__device__ __forceinline__ int crow(int r,int hi){return (r&3)+8*(r>>2)+4*hi;}
#define SBAR() __builtin_amdgcn_sched_barrier(0)
__device__ __forceinline__ void cmask(f32x16&p0,f32x16&p1,int jb,int qrel,int hi){
  const float NEG=-INFINITY; int kb=64*jb+4*hi;
  #pragma unroll
  for(int r=0;r<16;++r){int kv=kb+(r&3)+8*(r>>2); if(kv>qrel)p0[r]=NEG; if(kv+32>qrel)p1[r]=NEG;}
}

constexpr int NSLOT=3, SLOTB=8192;
constexpr int LDS_K=0, LDS_V=NSLOT*SLOTB, LDS_WS=2*NSLOT*SLOTB, LDS_OST=LDS_WS+NW*64*4, LDS_BYTES=LDS_OST+NW*4096;
constexpr float C2=0.125f*1.4426950408889634f;
__device__ __forceinline__ void glds16(const void*gsrc,unsigned lds_dst){unsigned keep;
  asm volatile("s_mov_b32 %0, m0\n\ts_mov_b32 m0, %2\n\ts_nop 0\n\tglobal_load_lds_dwordx4 %1, off\n\ts_mov_b32 m0, %0":"=&s"(keep):"v"(gsrc),"s"(lds_dst):"memory");}
__device__ __forceinline__ float max3f(float a,float b,float c){float r;asm("v_max3_f32 %0, %1, %2, %3":"=v"(r):"v"(a),"v"(b),"v"(c));return r;}
__device__ __forceinline__ float max2f(float a,float b){float r;asm("v_max_f32_e32 %0, %1, %2":"=v"(r):"v"(a),"v"(b));return r;}
__device__ __forceinline__ float fadd_s(float a,float b){float r;asm("v_add_f32_e32 %0, %1, %2":"=v"(r):"v"(a),"v"(b));return r;}
__device__ __forceinline__ float fsub_s(float a,float b){float r;asm("v_sub_f32_e32 %0, %1, %2":"=v"(r):"v"(a),"v"(b));return r;}
typedef float f32x2_t __attribute__((ext_vector_type(2))); typedef __bf16 bf16x2_t __attribute__((ext_vector_type(2)));
__device__ __forceinline__ unsigned cvtpk_s(float lo,float hi){f32x2_t v={lo,hi};bf16x2_t b=__builtin_convertvector(v,bf16x2_t);return __builtin_bit_cast(unsigned,b);}
#define WAIT_BAR(N) asm volatile("s_waitcnt vmcnt(" #N ") lgkmcnt(0)\n\ts_barrier":::"memory")

__device__ __forceinline__ void qkt(f32x16&p0,f32x16&p1,const char*Kslot,const bf16x8*qr,const f32x16&negm,int r32,int hi){
  const char*kb=Kslot+hi*1024+r32*16;
  #pragma unroll
  for(int d0=0;d0<4;++d0){
    const bf16x8 b0=*reinterpret_cast<const bf16x8*>(kb+d0*2048);
    const bf16x8 b1=*reinterpret_cast<const bf16x8*>(kb+d0*2048+512);
    if(d0==0){p0=__builtin_amdgcn_mfma_f32_32x32x16_bf16(b0,qr[0],negm,0,0,0);p1=__builtin_amdgcn_mfma_f32_32x32x16_bf16(b1,qr[0],negm,0,0,0);}
    else{p0=__builtin_amdgcn_mfma_f32_32x32x16_bf16(b0,qr[d0],p0,0,0,0);p1=__builtin_amdgcn_mfma_f32_32x32x16_bf16(b1,qr[d0],p1,0,0,0);}}
}
typedef __attribute__((address_space(3))) const char* lds_cptr;
typedef short v4i16_t __attribute__((ext_vector_type(4)));
__device__ __forceinline__ void kload8(bf16x8*kf,lds_cptr kp){
  kf[0]=*(const __attribute__((address_space(3))) bf16x8*)(kp);      kf[1]=*(const __attribute__((address_space(3))) bf16x8*)(kp+512);
  kf[2]=*(const __attribute__((address_space(3))) bf16x8*)(kp+2048); kf[3]=*(const __attribute__((address_space(3))) bf16x8*)(kp+2560);
  kf[4]=*(const __attribute__((address_space(3))) bf16x8*)(kp+4096); kf[5]=*(const __attribute__((address_space(3))) bf16x8*)(kp+4608);
  kf[6]=*(const __attribute__((address_space(3))) bf16x8*)(kp+6144); kf[7]=*(const __attribute__((address_space(3))) bf16x8*)(kp+6656);
}
__device__ __forceinline__ void kload2(bf16x8*kf,lds_cptr kp,int j){ kf[2*j]=*(const __attribute__((address_space(3))) bf16x8*)(kp+j*2048); kf[2*j+1]=*(const __attribute__((address_space(3))) bf16x8*)(kp+j*2048+512); }
__device__ __forceinline__ s16x4 vtr(lds_cptr p){ return __builtin_bit_cast(s16x4,__builtin_amdgcn_ds_read_tr16_b64_v4i16((__attribute__((address_space(3))) v4i16_t*)p)); }
__device__ __forceinline__ float rowmax(const f32x16&p0,const f32x16&p1){
  float a=max3f(p0[0],p0[1],p1[0]),b=max3f(p0[2],p0[3],p1[1]);a=max3f(a,p1[2],p1[3]);
  #pragma unroll
  for(int r=4;r<16;r+=4){a=max3f(a,p0[r],p0[r+1]);b=max3f(b,p0[r+2],p0[r+3]);a=max3f(a,p1[r],p1[r+1]);b=max3f(b,p1[r+2],p1[r+3]);}
  const float m=max2f(a,b);
  auto rr=__builtin_amdgcn_permlane32_swap(__float_as_uint(m),__float_as_uint(m),false,false);
  return max2f(__uint_as_float(rr[0]),__uint_as_float(rr[1]));
}
__device__ __forceinline__ void pv(f32x16*o,int vb,bf16x8 pa0,bf16x8 pa1,bf16x8 pa2,bf16x8 pa3){
  #pragma unroll
  for(int d0=0;d0<2;++d0){s16x4 lo[4],hi[4];
    #pragma unroll
    for(int ks=0;ks<4;++ks){
      asm volatile("ds_read_b64_tr_b16 %0,%1 offset:%c2":"=&v"(lo[ks]):"v"(vb),"i"(d0*4096+ks*1024):"memory");
      asm volatile("ds_read_b64_tr_b16 %0,%1 offset:%c2":"=&v"(hi[ks]):"v"(vb),"i"(d0*4096+ks*1024+512):"memory");}
    asm volatile("s_waitcnt lgkmcnt(0)":::"memory");SBAR();
    #define PK(k) (bf16x8){lo[k][0],lo[k][1],lo[k][2],lo[k][3],hi[k][0],hi[k][1],hi[k][2],hi[k][3]}
    o[d0]=__builtin_amdgcn_mfma_f32_32x32x16_bf16(pa0,PK(0),o[d0],0,0,0);
    o[d0]=__builtin_amdgcn_mfma_f32_32x32x16_bf16(pa1,PK(1),o[d0],0,0,0);
    o[d0]=__builtin_amdgcn_mfma_f32_32x32x16_bf16(pa2,PK(2),o[d0],0,0,0);
    o[d0]=__builtin_amdgcn_mfma_f32_32x32x16_bf16(pa3,PK(3),o[d0],0,0,0);
    #undef PK
  }
}

#ifndef ATTN_STORE16
#define ATTN_STORE16(p,v) (*(u32x4*)(p)=(v))
#endif
template<int THRL> __device__ __forceinline__ void attn_unit(int b,int h,int qb,const bf16*Q,const bf16*__restrict__ K,const bf16*__restrict__ V,bf16*O,char*shm){
  const int wid=__builtin_amdgcn_readfirstlane((int)threadIdx.x>>6); const int lane=lane_id_fresh(),r32=lane&31,hi=lane>>5;
  const long rowbase=(long)b*SEQ; const int q0=qb*QB;
  const bf16*Qw=Q+(rowbase+q0+wid*QBLK)*DM+h*D;
  const bf16*Kh=K+rowbase*KVP+(h>>2)*D,*Vh=V+rowbase*KVP+(h>>2)*D;
  const unsigned lds0=(unsigned)(uintptr_t)shm;
  float*wsf=(float*)(shm+LDS_WS)+wid*64;
  const bf16*ksrc=Kh+(long)lane*KVP+wid*8;
  const bf16*vsrc=Vh+(long)(16*(wid&3)+(lane>>2))*KVP+(wid>>2)*32+(lane&3)*8;
  const unsigned kdst=lds0+LDS_K+wid*1024, vdst=lds0+LDS_V+wid*1024;
  #define DMA_K(t,slot) glds16(ksrc+(long)(t)*KVBLK*KVP,(unsigned)__builtin_amdgcn_readfirstlane(kdst+(slot)))
  #define DMA_V(t,slot) glds16(vsrc+(long)(t)*KVBLK*KVP,(unsigned)__builtin_amdgcn_readfirstlane(vdst+(slot)))
  const int vb0=(int)(lds0+LDS_V)+((lane>>4)&1)*32+(lane&3)*8+(4*hi+((lane&15)>>2))*64;
  const char*Kbase=shm+LDS_K; bf16x8 kf[8];
  const lds_cptr shm3=(lds_cptr)shm; const lds_cptr kp0=shm3+LDS_K+hi*1024+r32*16; const lds_cptr vp0=shm3+LDS_V+((lane>>4)&1)*32+(lane&3)*8+(4*hi+((lane&15)>>2))*64;
  const int NT=SEQ/KVBLK;
  DMA_K(0,0);DMA_V(0,0);DMA_K(1,SLOTB);
  bf16x8 qr[4];
  #pragma unroll
  for(int d0=0;d0<4;++d0)qr[d0]=*reinterpret_cast<const bf16x8*>(&Qw[(long)r32*DM+d0*16+hi*8]);
  float l_reg=0.f;f32x16 o[2];o[0]=f32x16{};o[1]=f32x16{}; const f32x16 zz=f32x16{};

  #define CMASK(P0,P1,t) do{}while(0)
  f32x16 pA0,pA1,pB0,pB1;
  int sl_prev=0,sl_cur=0,sl_next=SLOTB;
  #define ROT() do{sl_prev=sl_cur;sl_cur=sl_next;sl_next=(sl_next==(NSLOT-1)*SLOTB)?0:sl_next+SLOTB;}while(0)
  DMA_K(2,2*SLOTB);
  WAIT_BAR(3);
  qkt(pA0,pA1,Kbase,qr,zz,r32,hi);
  _Pragma("unroll") for(int r=0;r<16;++r)pA0[r]=__builtin_amdgcn_exp2f(pA0[r]);
  _Pragma("unroll") for(int r=0;r<16;++r)pA1[r]=__builtin_amdgcn_exp2f(pA1[r]);
  WAIT_BAR(0);
  DMA_K(3,0);DMA_V(1,SLOTB);
  ROT();
  kload8(kf,kp0+sl_cur);
  WAIT_BAR(2);
  s16x4 vlo[8],vhi[8]; u32x4 pw0,pw1,pw2,pw3;
  #define PKW(P,B) cvtpk_s(P[B],P[B+1])
  #define PAF(k) __builtin_bit_cast(bf16x8,pw##k)
  #define VFR(i) (bf16x8){vlo[i][0],vlo[i][1],vlo[i][2],vlo[i][3],vhi[i][0],vhi[i][1],vhi[i][2],vhi[i][3]}
  #define PIN(x) asm volatile("":"+v"(x))
  #define MX3(a,b,c) __builtin_fmaxf(__builtin_fmaxf((a),(b)),(c))
  #define GAPA(MF,A0,A1,A2,A3,W0,W1,PW) do{ MF; sacc+=A0; sacc+=A1; sacc+=A2; sacc+=A3; PIN(sacc); W0; W1; PIN(PW); SBAR(); }while(0)
  #define EX(v) __builtin_amdgcn_exp2f(v)
  #define GAPB(MF,X,B) do{ MF; X[B]=EX(X[B]); X[B+1]=EX(X[B+1]); X[B+2]=EX(X[B+2]); X[B+3]=EX(X[B+3]); PIN(X); SBAR(); }while(0)
  #define VRD(i) do{ vlo[i]=vtr(vp_+(((i)>>2)*4096+((i)&3)*1024)); vhi[i]=vtr(vp_+(((i)>>2)*4096+((i)&3)*1024+512)); }while(0)
  #define KRD(G,j) do{ if(G){ kload2(kf,kp0+sl_next,j); SBAR(); } }while(0)
  #define STEP(C0,C1,P0,P1,t,GK,GV,GL) do{ SBAR(); \
    const lds_cptr vp_=vp0+sl_prev; \
    VRD(0); SBAR(); float sacc=(P0[0]+P0[1]); \
    GAPA(C0=__builtin_amdgcn_mfma_f32_32x32x16_bf16(kf[0],qr[0],zz,0,0,0), P0[2],P0[3],P0[4],P0[5],     pw0[0]=PKW(P0,0), pw0[1]=PKW(P0,2), pw0); \
    VRD(4); SBAR(); GAPA(C1=__builtin_amdgcn_mfma_f32_32x32x16_bf16(kf[1],qr[0],zz,0,0,0), P0[6],P0[7],P0[8],P0[9],     pw0[2]=PKW(P0,4), pw0[3]=PKW(P0,6), pw0); \
    VRD(1); SBAR(); GAPA(C0=__builtin_amdgcn_mfma_f32_32x32x16_bf16(kf[2],qr[1],C0,0,0,0),   P0[10],P0[11],P0[12],P0[13], pw1[0]=PKW(P0,8), pw1[1]=PKW(P0,10), pw1); \
    VRD(5); SBAR(); GAPA(C1=__builtin_amdgcn_mfma_f32_32x32x16_bf16(kf[3],qr[1],C1,0,0,0),   P0[14],P0[15],P1[0],P1[1],   pw1[2]=PKW(P0,12),pw1[3]=PKW(P0,14), pw1); \
    VRD(2); SBAR(); GAPA(C0=__builtin_amdgcn_mfma_f32_32x32x16_bf16(kf[4],qr[2],C0,0,0,0),   P1[2],P1[3],P1[4],P1[5],     pw2[0]=PKW(P1,0), pw2[1]=PKW(P1,2), pw2); \
    VRD(6); SBAR(); GAPA(C1=__builtin_amdgcn_mfma_f32_32x32x16_bf16(kf[5],qr[2],C1,0,0,0),   P1[6],P1[7],P1[8],P1[9],     pw2[2]=PKW(P1,4), pw2[3]=PKW(P1,6), pw2); \
    VRD(3); SBAR(); GAPA(C0=__builtin_amdgcn_mfma_f32_32x32x16_bf16(kf[6],qr[3],C0,0,0,0),   P1[10],P1[11],P1[12],P1[13], pw3[0]=PKW(P1,8), pw3[1]=PKW(P1,10), pw3); \
    VRD(7); SBAR(); GAPA(C1=__builtin_amdgcn_mfma_f32_32x32x16_bf16(kf[7],qr[3],C1,0,0,0),   P1[14],P1[15],0.f,0.f,       pw3[2]=PKW(P1,12),pw3[3]=PKW(P1,14), pw3); \
    l_reg+=sacc; \
    if(GK){DMA_K((t)+3,sl_cur);} if(GV){DMA_V((t)+1,sl_next);} \
    CMASK(C0,C1,t); \
    SBAR(); \
    GAPB(o[0]=__builtin_amdgcn_mfma_f32_32x32x16_bf16(PAF(0),VFR(0),o[0],0,0,0), C0,0); \
    GAPB(o[1]=__builtin_amdgcn_mfma_f32_32x32x16_bf16(PAF(0),VFR(4),o[1],0,0,0), C0,4); \
    KRD(GL,0); GAPB(o[0]=__builtin_amdgcn_mfma_f32_32x32x16_bf16(PAF(1),VFR(1),o[0],0,0,0), C0,8); \
    KRD(GL,1); GAPB(o[1]=__builtin_amdgcn_mfma_f32_32x32x16_bf16(PAF(1),VFR(5),o[1],0,0,0), C0,12); \
    KRD(GL,2); GAPB(o[0]=__builtin_amdgcn_mfma_f32_32x32x16_bf16(PAF(2),VFR(2),o[0],0,0,0), C1,0); \
    KRD(GL,3); GAPB(o[1]=__builtin_amdgcn_mfma_f32_32x32x16_bf16(PAF(2),VFR(6),o[1],0,0,0), C1,4); \
    GAPB(o[0]=__builtin_amdgcn_mfma_f32_32x32x16_bf16(PAF(3),VFR(3),o[0],0,0,0), C1,8); \
    GAPB(o[1]=__builtin_amdgcn_mfma_f32_32x32x16_bf16(PAF(3),VFR(7),o[1],0,0,0), C1,12); \
    }while(0)
  int t=1;
  #undef CMASK
  #define CMASK(P0,P1,t) do{}while(0)
  for(;t+5<NT;t+=2){
    STEP(pB0,pB1,pA0,pA1,t,true,true,true);     WAIT_BAR(2); ROT();
    STEP(pA0,pA1,pB0,pB1,t+1,true,true,true);   WAIT_BAR(2); ROT();
  }
  #undef CMASK
  #define CMASK(P0,P1,t) do{}while(0)
  #define ENDW(tt) do{ if((tt)+3<NT){WAIT_BAR(2);} else if((tt)+2<NT){WAIT_BAR(1);} else {WAIT_BAR(0);} }while(0)
  for(;t+1<NT;t+=2){
    STEP(pB0,pB1,pA0,pA1,t,(t+3<NT),(t+1<NT),(t+1<NT));       ENDW(t);   ROT();
    STEP(pA0,pA1,pB0,pB1,t+1,(t+4<NT),(t+2<NT),(t+2<NT));     ENDW(t+1); ROT();
  }
  STEP(pB0,pB1,pA0,pA1,NT-1,false,false,false);
  { float sacc=pB0[0]+pB0[1]; _Pragma("unroll") for(int r=2;r<16;++r)sacc+=pB0[r]; _Pragma("unroll") for(int r=0;r<16;++r)sacc+=pB1[r]; l_reg+=sacc;
    pw0=(u32x4){PKW(pB0,0),PKW(pB0,2),PKW(pB0,4),PKW(pB0,6)};pw1=(u32x4){PKW(pB0,8),PKW(pB0,10),PKW(pB0,12),PKW(pB0,14)};pw2=(u32x4){PKW(pB1,0),PKW(pB1,2),PKW(pB1,4),PKW(pB1,6)};pw3=(u32x4){PKW(pB1,8),PKW(pB1,10),PKW(pB1,12),PKW(pB1,14)};
    SBAR(); pv(o,vb0+sl_cur,PAF(0),PAF(1),PAF(2),PAF(3)); }
  #undef PKW
  #undef PAF
  #undef VFR
  #undef PIN
  #undef MX3
  #undef GAPA
  #undef GAPB
  #undef EX
  #undef VRD
  #undef KRD
  #undef STEP
  #undef ENDW
  {auto rr=__builtin_amdgcn_permlane32_swap(__float_as_uint(l_reg),__float_as_uint(l_reg),false,false);l_reg=__uint_as_float(rr[0])+__uint_as_float(rr[1]);}
  if(hi==0)wsf[32+r32]=l_reg;asm volatile("s_waitcnt lgkmcnt(0)":::"memory");
  float rli[16];
  #pragma unroll
  for(int r=0;r<16;++r)rli[r]=__builtin_amdgcn_rcpf(wsf[32+crow(r,hi)]);
  bf16*Ow=O+(rowbase+q0+wid*QBLK)*DM+h*D;
  { bf16*stg=(bf16*)(shm+LDS_OST)+wid*2048;
    #pragma unroll
    for(int r=0;r<16;++r){const int orow=crow(r,hi);
      #pragma unroll
      for(int d0=0;d0<2;++d0)stg[orow*64+d0*32+r32]=__float2bfloat16(o[d0][r]*rli[r]);}
    asm volatile("s_waitcnt lgkmcnt(0)":::"memory");
    #pragma unroll
    for(int i=0;i<4;++i){const int row=i*8+(lane>>3),ch=lane&7; const u32x4 v=*(const u32x4*)(stg+row*64+ch*8); ATTN_STORE16(Ow+(long)row*DM+ch*8,v);} }
  asm volatile("s_waitcnt lgkmcnt(0)\n\ts_barrier":::"memory");
  #undef DMA_K
  #undef DMA_V
  #undef CMASK
  #undef START
  #undef RESC
  #undef ROT
}
constexpr int ATTN_LDS_BYTES=LDS_BYTES;
struct AttnOrder { int vcu, G;
  __device__ __forceinline__ bool next(int i,int&b,int&h,int&qb)const{
    int g,u;
    if(G==256){ if(i>=8)return false; g=4*(vcu>>5)+(i>>1); u=2*(vcu&31)+(i&1); }
    else { const int L=i*G+vcu; if(L>=2048)return false; g=L>>6; u=L&63; }
    b=g>>2; h=(g&3)*4+(u>>4); qb=u&15; return true; }
};
#undef SBAR
#undef WAIT_BAR
}

#ifndef DBG_SKIP
#define DBG_SKIP 0
#endif
#ifndef DBG_P0VAR
#define DBG_P0VAR 0
#endif
#ifndef DBG_SCANVAR
#define DBG_SCANVAR -1
#endif
#ifndef DBG_REPEAT
#define DBG_REPEAT 0
#endif
constexpr int NWAVES = 8;
constexpr int N_LAUNCHES = MK_N_LAUNCHES;
constexpr int PER_PHASE = 8;
static_assert(N_LAUNCHES == 1 || N_LAUNCHES == PER_PHASE, "MK_N_LAUNCHES is 1 or 8");

constexpr int BATCH = 8, SEQ = 4096, D = 1024, M = BATCH * SEQ, DIN = 5632, DFF = 2816;
constexpr float LOG2E = 1.4426950408889634f;

constexpr size_t MiB = 1u << 20;
constexpr size_t WS_CTL = 0, CTL_ZERO_BYTES = 64 * 1024;
constexpr size_t WS_ROPE = 1 * MiB;
constexpr size_t WS_WIN = 2 * MiB, WS_WPR = 13 * MiB, WS_WPA = 15 * MiB, WS_WO = 17 * MiB, WS_WFI = 19 * MiB, WS_WFO = 30 * MiB;
constexpr size_t WS_SSQ = 36 * MiB;
constexpr size_t WS_SCW = 38 * MiB;
constexpr size_t WS_SCB = 42 * MiB;
constexpr size_t WS_U = 48 * MiB;
constexpr size_t WS_RX = 112 * MiB;
constexpr size_t WS_GG = 176 * MiB;
constexpr size_t WS_Q = 240 * MiB;
constexpr size_t WS_K = 304 * MiB, WS_V = 320 * MiB;
constexpr size_t WS_SR = 336 * MiB, WS_SA = 400 * MiB;
constexpr size_t WS_F = 176 * MiB;
constexpr size_t WS_END = 464 * MiB;
static_assert(WS_WFO + (size_t)D * DFF * 2 <= WS_SSQ && WS_SSQ + (size_t)M * 16 * 4 <= WS_U && WS_F + (size_t)M * DFF * 2 <= WS_SA, "d_ws map");
constexpr int CW_BAR = 1024;

constexpr int RING_OFF = 0, RING_BYTES = 131072;
constexpr int LDSCTL_OFF = RING_BYTES, MISC_OFF = LDSCTL_OFF + 320, LDSCTL_BYTES = 1024, TAB_OFF = LDSCTL_OFF + LDSCTL_BYTES;
constexpr int LDS_BYTES = 163840;
constexpr int SC_XP = 141312;
static_assert(MISC_OFF + 128 <= LDSCTL_OFF + LDSCTL_BYTES && TAB_OFF + (128 + 2048) * 4 <= SC_XP && SC_XP + 8 * 2048 <= LDS_BYTES, "LDS map");

#define GAS __attribute__((address_space(1)))
#define LAS __attribute__((address_space(3)))
typedef unsigned short bf16;
typedef unsigned v4u __attribute__((ext_vector_type(4)));
typedef float f32x4 __attribute__((ext_vector_type(4)));
typedef short bf16x8 __attribute__((ext_vector_type(8)));
typedef GAS unsigned gu32;
typedef GAS unsigned long long gu64;
#define RLX_AGENT __ATOMIC_RELAXED, __HIP_MEMORY_SCOPE_AGENT
#define LDS_WAIT() asm volatile("s_waitcnt lgkmcnt(0)" ::: "memory")
#define VM_WAIT() asm volatile("s_waitcnt vmcnt(0)" ::: "memory")
__device__ __forceinline__ unsigned long long rt() { return __builtin_amdgcn_s_memrealtime(); }
__device__ __forceinline__ unsigned pk2(float lo, float hi) { return pg8::cvt_pk_bf16(lo, hi); }
__device__ __forceinline__ unsigned f2bf(float f) { return pg8::cvt_pk_bf16(f, f) & 0xffffu; }

#define XB_TMO      128
#define XB_XCNT(j)  (256  + 64 * (j))
#define XB_XSUB(j)  (1280 + 64 * (j))
#define XB_XGEN(j)  (2304 + 64 * (j))
#define XB_TOP      3328
#define XB_TOPGEN   3392
#define XCD_BAR_WORDS 3456
#define XB_SPIN_CAP (1u << 18)

__device__ __forceinline__ unsigned xb_ld(unsigned* p)              { return __hip_atomic_load(p, __ATOMIC_RELAXED, __HIP_MEMORY_SCOPE_AGENT); }
__device__ __forceinline__ unsigned xb_add(unsigned* p, unsigned v) { return __hip_atomic_fetch_add(p, v, __ATOMIC_RELAXED, __HIP_MEMORY_SCOPE_AGENT); }
__device__ __forceinline__ unsigned xb_xcc_id() { return (unsigned)__builtin_amdgcn_s_getreg((3 << 11) | 20) & 0xFu; }
#define XB_SPIN(cond, bar) do { unsigned _sp = 0; while (cond) { __builtin_amdgcn_s_sleep(1); \
    if ((++_sp & 255u) == 0u) { if (xb_ld(&(bar)[XB_TMO])) break; if (_sp > XB_SPIN_CAP) { atomicAdd(&(bar)[XB_TMO], 1u); break; } } } } while (0)

struct XcdBarrier {
    unsigned* bar; unsigned x;
    volatile LAS unsigned* st;
};

__device__ __forceinline__ XcdBarrier xcd_barrier_post(unsigned* bar, volatile LAS unsigned* st) {
    XcdBarrier b; b.bar = bar; b.x = xb_xcc_id(); b.st = st;
    if (threadIdx.x == 0) (void)xb_add(&bar[XB_XCNT(b.x)], 1u);
    return b;
}
__device__ __forceinline__ void xcd_barrier_complete(unsigned* bar, unsigned x, unsigned& nloc, unsigned& nx) {
    const unsigned G = gridDim.x * gridDim.y * gridDim.z;
    unsigned sum, cnt, mine, sp = 0u;
    for (;;) {
        sum = 0u; cnt = 0u; mine = 0u;
#pragma unroll
        for (unsigned j = 0; j < 16; ++j) { const unsigned c = xb_ld(&bar[XB_XCNT(j)]); sum += c; cnt += (c > 0u) ? 1u : 0u; mine = (j == x) ? c : mine; }
        if (sum == G) break;
        __builtin_amdgcn_s_sleep(1);
        if ((++sp & 255u) == 0u) { if (xb_ld(&bar[XB_TMO])) break; if (sp > XB_SPIN_CAP) { atomicAdd(&bar[XB_TMO], 1u); break; } }
    }
    nloc = mine > 0u ? mine : 1u; nx = cnt > 0u ? cnt : 1u;
}

__device__ __forceinline__ void xcd_barrier(const XcdBarrier& b) {
    asm volatile("s_waitcnt vmcnt(0)" ::: "memory");
    __syncthreads();
    if (threadIdx.x == 0) {
        unsigned* bar = b.bar;
        __builtin_amdgcn_s_waitcnt(0);
        unsigned nloc = b.st[0], nx = b.st[1];
        if (nloc == 0u) { xcd_barrier_complete(bar, b.x, nloc, nx); b.st[0] = nloc; b.st[1] = nx; }
        const unsigned old = xb_add(&bar[XB_XSUB(b.x)], 1u);
        const unsigned gen = old / nloc;
        if (old + 1u == (gen + 1u) * nloc) {
            __builtin_amdgcn_fence(__ATOMIC_RELEASE, "agent");
            asm volatile("s_waitcnt vmcnt(0)" ::: "memory");
            const unsigned og = xb_add(&bar[XB_TOP], 1u);
            const unsigned tg = og / nx;
            if (og + 1u == (tg + 1u) * nx) xb_add(&bar[XB_TOPGEN], 1u);
            else XB_SPIN(xb_ld(&bar[XB_TOPGEN]) == tg, bar);
            __builtin_amdgcn_fence(__ATOMIC_ACQUIRE, "agent");
            xb_add(&bar[XB_XGEN(b.x)], 1u);
            asm volatile("s_waitcnt vmcnt(0)" ::: "memory");
        } else {
            XB_SPIN(xb_ld(&bar[XB_XGEN(b.x)]) == gen, bar);
            __builtin_amdgcn_fence(__ATOMIC_ACQUIRE, "agent");
            asm volatile("s_waitcnt vmcnt(0)" ::: "memory");
        }
    }
    __syncthreads();
}


using pg8::bf_lo; using pg8::bf_hi; using pg8::sigmoid_f;
struct Frame {
    LAS unsigned char* lds;
    volatile LAS unsigned* MISC;
    gu32* ctl;
    int tid, lane, wave;
    int vcu, G;
    const float* x; float* out;
    const float *norm1_g, *w_in, *conv_w, *conv_b, *wa_f, *ba_f, *wx_f, *bx_f, *lam_f, *wa_b, *ba_b, *wx_b, *bx_b, *lam_b, *q_norm_g, *k_norm_g, *p_rnn, *p_attn, *w_o, *norm2_g, *w_ffn_in, *w_ffn_out;
    bf16 *Win_t, *Wpr_t, *Wpa_t, *Wo_t, *Wfi_t, *Wfo_t;
    bf16 *U, *RX, *GG, *HG, *Q, *K, *V, *SR, *SA, *MG, *X1B, *Fb;
    float *ROPE, *SSQ, *SCB; bf16* SCW;
};

__device__ __forceinline__ float wave_sum(float v) {
#pragma unroll
    for (int o = 1; o < 64; o <<= 1) v += __shfl_xor(v, o);
    return v;
}
__device__ __forceinline__ void p0_transpose_item64(const float* W, int K, int N, bf16* WT, int src_a, int src_b, int dst_row0, int k0, const float* kscale, LAS float* scr, int lane) {
    const int c4 = (lane & 15) * 4, rr = lane >> 4, scol = (c4 < 32 ? src_a : src_b - 32) + c4;
    f32x4 v[16];
#pragma unroll
    for (int i = 0; i < 16; ++i) v[i] = *(const GAS f32x4*)(W + (size_t)(k0 + 4 * i + rr) * N + scol);
#pragma unroll
    for (int i = 0; i < 16; ++i) { const int kk = 4 * i + rr; f32x4 t = v[i]; if (kscale) t = t * kscale[k0 + kk];
        LAS float* d = scr + kk * 65 + c4; d[0] = t.x; d[1] = t.y; d[2] = t.z; d[3] = t.w; }
    LDS_WAIT(); asm volatile("" ::: "memory");
    const int c = lane & 7;
#pragma unroll
    for (int j = 0; j < 8; ++j) { const int n = (lane >> 3) + 8 * j; const LAS float* s = scr + (8 * c) * 65 + n;
        v4u o; o.x = pk2(s[0 * 65], s[1 * 65]); o.y = pk2(s[2 * 65], s[3 * 65]); o.z = pk2(s[4 * 65], s[5 * 65]); o.w = pk2(s[6 * 65], s[7 * 65]);
        *(GAS v4u*)(WT + (size_t)(dst_row0 + n) * K + k0 + 8 * c) = o; }
    LDS_WAIT(); asm volatile("" ::: "memory");
}
template <int NR> __device__ __forceinline__ void rms_rows_to_bf16(Frame& F, const float* xrow, const float* g, bf16* orow) {
    const GAS f32x4* xr = (const GAS f32x4*)xrow + F.lane; const GAS f32x4* gr = (const GAS f32x4*)g + F.lane;
    f32x4 v[NR][4], gg[4]; float rs[NR];
#pragma unroll
    for (int j = 0; j < 4; ++j) gg[j] = gr[64 * j];
#pragma unroll
    for (int r = 0; r < NR; ++r)
#pragma unroll
        for (int j = 0; j < 4; ++j) v[r][j] = __builtin_nontemporal_load(&xr[256 * r + 64 * j]);
#pragma unroll
    for (int r = 0; r < NR; ++r) { float s = 0.f;
#pragma unroll
        for (int j = 0; j < 4; ++j) s += (v[r][j].x * v[r][j].x + v[r][j].y * v[r][j].y) + (v[r][j].z * v[r][j].z + v[r][j].w * v[r][j].w);
        rs[r] = s; }
#pragma unroll
    for (int o = 1; o < 64; o <<= 1)
#pragma unroll
        for (int r = 0; r < NR; ++r) rs[r] += __shfl_xor(rs[r], o);
#pragma unroll
    for (int r = 0; r < NR; ++r) rs[r] = 1.f / sqrtf(rs[r] * (1.f / D) + 1e-6f);
    GAS unsigned long long* o8 = (GAS unsigned long long*)orow + F.lane;
#pragma unroll
    for (int j = 0; j < 4; ++j) { const f32x4 g4 = gg[j];
#pragma unroll
        for (int r = 0; r < NR; ++r) o8[256 * r + 64 * j] = (unsigned long long)pk2(v[r][j].x * rs[r] * g4.x, v[r][j].y * rs[r] * g4.y) | ((unsigned long long)pk2(v[r][j].z * rs[r] * g4.z, v[r][j].w * rs[r] * g4.w) << 32); }
}
template <int VAR> __device__ __forceinline__ void p0_prologue(Frame& F) {
    const int w = F.wave;
    if (VAR != 1) {
        const int gw = F.vcu * NWAVES + w, NGW = F.G * NWAVES;
        for (int m = 4 * gw; m < M; m += 4 * NGW) rms_rows_to_bf16<4>(F, F.x + (size_t)m * D, F.norm1_g, F.U + (size_t)m * D);
    }
    if (VAR != 2) {
        LAS float* scr = (LAS float*)(F.lds + (w < 7 ? RING_OFF + w * 16640 : TAB_OFF));
        const int gw = F.vcu * NWAVES + w, NGW = F.G * NWAVES;
        constexpr int I_IN = (D / 64) * (DIN / 64), I_SQ = (D / 64) * (D / 64), I_FI = I_IN, I_FO = (DFF / 64) * (D / 64);
        constexpr int NITEMS = I_IN + 3 * I_SQ + I_FI + I_FO;
        for (int it = gw; it < NITEMS; it += NGW) {
            int r = it;
            if (r < I_IN) { const int kb = r / (DIN / 64), n0 = 64 * (r % (DIN / 64)), tile = n0 >> 8, pp = n0 & 255;
                int sa = n0, sb = n0 + 32;
                if (tile >= 8 && tile <= 12) { sa = tile * 256 + 64 * ((pp >> 5) & 3) + 32 * (pp >> 7); sb = tile * 256 + 64 * (((pp + 32) >> 5) & 3) + 32 * ((pp + 32) >> 7); }
                p0_transpose_item64(F.w_in, D, DIN, F.Win_t, sa, sb, n0, 64 * kb, nullptr, scr, F.lane); continue; } r -= I_IN;
            if (r < I_SQ) { const int n0 = 64 * (r % 16); p0_transpose_item64(F.p_rnn, D, D, F.Wpr_t, n0, n0 + 32, n0, 64 * (r / 16), nullptr, scr, F.lane); continue; } r -= I_SQ;
            if (r < I_SQ) { const int n0 = 64 * (r % 16); p0_transpose_item64(F.p_attn, D, D, F.Wpa_t, n0, n0 + 32, n0, 64 * (r / 16), nullptr, scr, F.lane); continue; } r -= I_SQ;
            if (r < I_SQ) { const int n0 = 64 * (r % 16); p0_transpose_item64(F.w_o, D, D, F.Wo_t, n0, n0 + 32, n0, 64 * (r / 16), nullptr, scr, F.lane); continue; } r -= I_SQ;
            if (r < I_FI) { const int kb = r / (DIN / 64), n0 = 64 * (r % (DIN / 64)), pn = n0 >> 8, pp = n0 & 255;
                const int src = (pp >> 7) * DFF + 128 * pn + (pp & 127);
                p0_transpose_item64(F.w_ffn_in, D, DIN, F.Wfi_t, src, src + 32, n0, 64 * kb, F.norm2_g, scr, F.lane); continue; } r -= I_FI;
            { const int n0 = 64 * (r % 16); p0_transpose_item64(F.w_ffn_out, DFF, D, F.Wfo_t, n0, n0 + 32, n0, 64 * (r / 16), nullptr, scr, F.lane); }
        }
    }
    if (VAR != 3) {
        const int gt = F.vcu * (NWAVES * 64) + F.tid, NTH = F.G * (NWAVES * 64);
        if (gt < 1024) { const int pos = gt >> 4, i = gt & 15; double inv = 1.0; for (int k = 0; k < i; ++k) inv *= 0.5623413251903491;
            const double ang = (double)pos * inv, q = __builtin_rint(ang * 0.6366197723675814);
            double r = __builtin_fma(-q, 1.5707963267948966, ang); r = __builtin_fma(-q, 6.123233995736766e-17, r);
            const double r2 = r * r;
            double sn = 1.0 / 1307674368000.0; sn = sn * r2 - 1.0 / 6227020800.0; sn = sn * r2 + 1.0 / 39916800.0; sn = sn * r2 - 1.0 / 362880.0; sn = sn * r2 + 1.0 / 5040.0; sn = sn * r2 - 1.0 / 120.0; sn = sn * r2 + 1.0 / 6.0; sn = -sn * r2 + 1.0; sn *= r;
            double cs = 1.0 / 20922789888000.0; cs = cs * r2 - 1.0 / 87178291200.0; cs = cs * r2 + 1.0 / 479001600.0; cs = cs * r2 - 1.0 / 3628800.0; cs = cs * r2 + 1.0 / 40320.0; cs = cs * r2 - 1.0 / 720.0; cs = cs * r2 + 1.0 / 24.0; cs = cs * r2 - 0.5; cs = cs * r2 + 1.0;
            const int qi = (int)q & 3; const double c = qi == 0 ? cs : qi == 1 ? -sn : qi == 2 ? -cs : sn, s = qi == 0 ? sn : qi == 1 ? cs : qi == 2 ? -sn : -cs;
            F.ROPE[gt * 2] = (float)c; F.ROPE[gt * 2 + 1] = (float)s; }
        const float *waf_ = F.wa_f, *wab_ = F.wa_b, *wxf_ = F.wx_f, *wxb_ = F.wx_b, *cw_ = F.conv_w, *cb_ = F.conv_b;
#pragma unroll 1
        for (int e16 = gt; e16 < 4096 * 16; e16 += NTH) {
            const int e = e16 >> 4, pt = e16 & 15, gate = e & 1, cc = (e >> 1) & 1023, dir = e >> 11, blk = cc >> 6, col = cc & 63;
            const float* W = (gate ? (dir ? wxb_ : wxf_) : (dir ? wab_ : waf_)) + blk * 4096; float s = 0.f;
#pragma unroll
            for (int i = 4 * pt; i < 4 * pt + 4; ++i) s += cb_[blk * 64 + i] * W[i * 64 + col];
            s += __shfl_xor(s, 1); s += __shfl_xor(s, 2); s += __shfl_xor(s, 4); s += __shfl_xor(s, 8);
            if (pt == 0) F.SCB[e] = s; }
#pragma unroll 2
        for (int e = gt; e < 2 * 16 * 2 * 3072; e += NTH) {
            const int ent = e % 3072, r3 = e / 3072, half = r3 & 1, blk = (r3 >> 1) & 15, dir = r3 >> 5;
            const int nn = ent & 31, hh = (ent >> 5) & 1, sp = (ent >> 6) & 15, cblk = ent >> 10, k = sp >> 2, i0 = 16 * (sp & 3) + 8 * hh, col = half * 32 + nn;
            const float* wa = (dir ? wab_ : waf_) + blk * 4096; const float* wx = (dir ? wxb_ : wxf_) + blk * 4096;
            float v[8];
#pragma unroll
            for (int j = 0; j < 8; ++j) { const int i = i0 + j; const float cwv = cw_[k * 1024 + blk * 64 + i];
                v[j] = cblk == 0 ? -LOG2E * cwv * wa[i * 64 + col] : cblk == 1 ? -LOG2E * cwv * wx[i * 64 + col] : (i == col ? cwv : 0.f); }
            v4u o; o.x = pk2(v[0], v[1]); o.y = pk2(v[2], v[3]); o.z = pk2(v[4], v[5]); o.w = pk2(v[6], v[7]);
            *(GAS v4u*)(F.SCW + (size_t)e * 8) = o; }
    }
}

typedef float f32x16 __attribute__((ext_vector_type(16)));
constexpr int SC_ROWB = 144, SC_TILEB = 260 * SC_ROWB, SC_TILE0 = 0, SC_BW = 2 * SC_TILEB, SC_WAB = SC_BW + 49152, SC_END = SC_WAB + 4096;
static_assert(SC_END <= RING_BYTES, "scan LDS map");
__device__ __forceinline__ int crow16(int r, int hi) { return (r & 3) + 8 * (r >> 2) + 4 * hi; }
template <int DIR, int VAR> __device__ __forceinline__ void scan_sweep(Frame& F, int b, int blk, int half, bf16* HGdst) {
    const int lane = F.lane, w = F.wave, n = lane & 31, hi = lane >> 5, tid = F.tid;
    const int c = blk * 64 + half * 32 + n;
    LAS unsigned char* lds = F.lds;
    const float* wa = (DIR ? F.wa_b : F.wa_f) + blk * 4096; const float* wx = (DIR ? F.wx_b : F.wx_f) + blk * 4096;
    __syncthreads();
    { const GAS v4u* src = (const GAS v4u*)(F.SCW + (size_t)((DIR * 16 + blk) * 2 + half) * 3072 * 8) + tid; v4u t_[6];
#pragma unroll
      for (int i = 0; i < 6; ++i) t_[i] = src[i * (NWAVES * 64)];
#pragma unroll
      for (int i = 0; i < 6; ++i) *(LAS v4u*)(lds + SC_BW + (tid + i * (NWAVES * 64)) * 16) = t_[i]; }
    const float cbr = F.SCB[(DIR * 1024 + c) * 2], cbi = F.SCB[(DIR * 1024 + c) * 2 + 1];
    const float ini_r = -LOG2E * ((DIR ? F.ba_b : F.ba_f)[c] + cbr), ini_i = -LOG2E * ((DIR ? F.bx_b : F.bx_f)[c] + cbi), ini_x = F.conv_b[c];
    float k8;
    { const float lam = (DIR ? F.lam_b : F.lam_f)[c]; const float e = __builtin_amdgcn_exp2f(-fabsf(lam) * LOG2E);
      const float l1p = e < 0.05f ? e * (1.0f + e * (-0.5f + e * (0.33333333f + e * (-0.25f + e * (0.2f + e * (-0.16666667f)))))) : __logf(1.0f + e);
      k8 = 8.0f * (fmaxf(-lam, 0.0f) + l1p); }
    const float ka = -k8 * LOG2E;
    const bf16* rxb = F.RX + (size_t)b * SEQ * D + blk * 64;
    bf16* outb = (bf16*)F.out + (size_t)b * SEQ * D; const bf16* ggb = F.GG + (size_t)b * SEQ * D; bf16* hgb = HGdst + (size_t)b * SEQ * D;
    v4u pf[5];
#define SC_LOAD(t0_) do { _Pragma("unroll") for (int i_ = 0; i_ < 5; ++i_) { const int p_ = tl + i_ * (NWAVES * 64), t_ = (t0_) - 2 + (p_ >> 3); \
        pf[i_] = (v4u){0u, 0u, 0u, 0u}; if (p_ < 260 * 8 && t_ >= 0 && t_ < SEQ) pf[i_] = *(const GAS v4u*)(rxb + (unsigned)(t_ * D + (p_ & 7) * 8)); } } while (0)
#define SC_WRITE(tile_) do { _Pragma("unroll") for (int i_ = 0; i_ < 5; ++i_) { const int p_ = tl + i_ * (NWAVES * 64); \
        if (p_ < 260 * 8) *(LAS v4u*)(lds + (tile_) + (p_ >> 3) * SC_ROWB + (p_ & 7) * 16) = pf[i_]; } } while (0)
    int tl = tid; unsigned lo_ = (unsigned)(32 * w + 4 * hi) * D + c;
    asm volatile("" : "+v"(tl), "+v"(lo_));
    const bool grpB = w >= 4;
    LAS unsigned char* xb = lds + SC_XP + w * 2048;
    SC_LOAD(DIR ? 15 * 256 : 0); SC_WRITE(SC_TILE0);
    SC_LOAD(DIR ? 14 * 256 : 256);
    float carry = 0.f;
    const int aoff = (32 * w + n) * SC_ROWB + 16 * hi, boff = SC_BW + (hi * 32 + n) * 16;
    f32x16 rp, ip, xo;
#pragma unroll
    for (int q = 0; q < 16; ++q) { rp[q] = 0.f; ip[q] = 0.f; xo[q] = 0.f; }
    float A[16], Bv[16], loA[4], loB[4], hiA[4], hiB[4]; unsigned hg2[16];
#pragma unroll
    for (int q = 0; q < 16; ++q) { A[q] = 0.f; Bv[q] = 0.f; hg2[q] = 0u; }
#pragma unroll
    for (int g = 0; g < 4; ++g) { loA[g] = 0.f; loB[g] = 0.f; hiA[g] = 0.f; hiB[g] = 0.f; }
#pragma unroll 1
    for (int s = 0; s < 34; ++s) {
        asm volatile("" : "+v"(tl), "+v"(lo_));
        __syncthreads();
        const int sm = s - (grpB ? 1 : 0);
        const int ckt = (s - 3) >> 1;
        if (VAR != 4 && !(s & 1)) { const int ckn = (s >> 1) + 1;
            if (ckn < 16) SC_WRITE((ckn & 1) * SC_TILEB);
            if (ckn + 1 < 16) SC_LOAD((DIR ? 15 - (ckn + 1) : ckn + 1) * 256); }
        if (VAR != 3 && (s & 1) && s >= 3) {
            const int t0 = (DIR ? 15 - ckt : ckt) * 256;
            const LAS float* WABr = (const LAS float*)(lds + SC_WAB) + (ckt & 1) * 512;
            float x = carry, cinw = 0.f;
#pragma unroll
            for (int i = 0; i < 8; ++i) { const int ww = DIR ? 7 - i : i; const float a = WABr[(ww * 32 + n) * 2], bq = WABr[(ww * 32 + n) * 2 + 1]; if (ww == w) cinw = x; x = a * x + bq; }
            carry = x;
            x = cinw;
#define SC_OUT(q_, hv_) do { const float o_ = DIR == 0 ? (hv_) : (__uint_as_float(hg2[q_] << 16) + (hv_)) * __uint_as_float(hg2[q_] & 0xffff0000u); \
                *(LAS unsigned short*)(xb + (((q_) & 3) + 8 * ((q_) >> 2) + 4 * hi) * 64 + n * 2) = (unsigned short)f2bf(o_); } while (0)
            if (DIR == 0) {
#pragma unroll
                for (int g = 0; g < 4; ++g) { const float x0 = x, x1 = loA[g] * x0 + loB[g], cin = hi ? x1 : x0; x = hiA[g] * x1 + hiB[g];
#pragma unroll
                    for (int j = 0; j < 4; ++j) SC_OUT(4 * g + j, Bv[4 * g + j] + A[4 * g + j] * cin); }
            } else {
#pragma unroll
                for (int g = 3; g >= 0; --g) { const float x0 = x, x1 = hiA[g] * x0 + hiB[g], cin = hi ? x0 : x1; x = loA[g] * x1 + loB[g];
#pragma unroll
                    for (int j = 0; j < 4; ++j) SC_OUT(4 * g + j, Bv[4 * g + j] + A[4 * g + j] * cin); }
            }
#undef SC_OUT
            { const v4u o0 = *(const LAS v4u*)(xb + lane * 16), o1 = *(const LAS v4u*)(xb + 1024 + lane * 16);
              bf16* dst = (DIR == 0 ? outb : hgb) + (unsigned)(t0 + 32 * w + (lane >> 2)) * D + (blk * 64 + half * 32 + (lane & 3) * 8);
              *(GAS v4u*)dst = o0; *(GAS v4u*)(dst + 16 * D) = o1; }
        }
        if (VAR != 1 && sm >= 0 && !(sm & 1) && (sm >> 1) < 16) {
            unsigned abase = ((sm >> 1) & 1) * SC_TILEB + aoff, bbase = boff;
            asm volatile("" : "+v"(abase), "+v"(bbase));
#pragma unroll
            for (int q = 0; q < 16; ++q) { rp[q] = ini_r; ip[q] = ini_i; xo[q] = ini_x; }
#pragma unroll
            for (int sp = 0; sp < 16; ++sp) {
                const bf16x8 afr = *(const LAS bf16x8*)(lds + abase + (sp >> 2) * SC_ROWB + (sp & 3) * 32);
                const bf16x8 b0 = *(const LAS bf16x8*)(lds + bbase + (0 * 16 + sp) * 1024), b1 = *(const LAS bf16x8*)(lds + bbase + (1 * 16 + sp) * 1024), b2 = *(const LAS bf16x8*)(lds + bbase + (2 * 16 + sp) * 1024);
                rp = __builtin_amdgcn_mfma_f32_32x32x16_bf16(afr, b0, rp, 0, 0, 0);
                ip = __builtin_amdgcn_mfma_f32_32x32x16_bf16(afr, b1, ip, 0, 0, 0);
                xo = __builtin_amdgcn_mfma_f32_32x32x16_bf16(afr, b2, xo, 0, 0, 0);
                if (sp & 1) __builtin_amdgcn_sched_barrier(0);
            }
        }
        if (VAR != 2 && sm >= 1 && (sm & 1) && ((sm - 1) >> 1) < 16) {
            const int ck = (sm - 1) >> 1, t0 = (DIR ? 15 - ck : ck) * 256;
            v4u h0, h1, g0, g1;
            if (DIR && VAR != 5) { const unsigned po = (unsigned)(t0 + 32 * w + (lane >> 2)) * D + (blk * 64 + half * 32 + (lane & 3) * 8);
                h0 = *(const GAS v4u*)(outb + po); h1 = *(const GAS v4u*)(outb + po + 16 * D); g0 = *(const GAS v4u*)(ggb + po); g1 = *(const GAS v4u*)(ggb + po + 16 * D); }
#pragma unroll
            for (int q = 0; q < 16; ++q) {
                const float r = __builtin_amdgcn_rcpf(1.0f + __builtin_amdgcn_exp2f(rp[q])), ig = __builtin_amdgcn_rcpf(1.0f + __builtin_amdgcn_exp2f(ip[q]));
                const float a = __builtin_amdgcn_exp2f(ka * r);
                A[q] = a;
                Bv[q] = __builtin_amdgcn_sqrtf(fmaxf(__builtin_fmaf(-a, a, 1.0f), 0.f)) * ig * xo[q]; }
#pragma unroll
            for (int g = 0; g < 4; ++g) {
                if (DIR == 0) {
#pragma unroll
                    for (int j = 1; j < 4; ++j) { const int q = 4 * g + j; Bv[q] = A[q] * Bv[q - 1] + Bv[q]; A[q] *= A[q - 1]; }
                } else {
#pragma unroll
                    for (int j = 2; j >= 0; --j) { const int q = 4 * g + j; Bv[q] = A[q] * Bv[q + 1] + Bv[q]; A[q] *= A[q + 1]; }
                }
                const float sA = A[4 * g + (DIR ? 0 : 3)], sB = Bv[4 * g + (DIR ? 0 : 3)];
                const auto ra = __builtin_amdgcn_permlane32_swap(__float_as_uint(sA), __float_as_uint(sA), false, false);
                const auto rb = __builtin_amdgcn_permlane32_swap(__float_as_uint(sB), __float_as_uint(sB), false, false);
                loA[g] = __uint_as_float(ra[0]); hiA[g] = __uint_as_float(ra[1]); loB[g] = __uint_as_float(rb[0]); hiB[g] = __uint_as_float(rb[1]);
            }
            float WA = 1.f, WB = 0.f;
            if (DIR == 0) {
#pragma unroll
                for (int g = 0; g < 4; ++g) { WB = loA[g] * WB + loB[g]; WA *= loA[g]; WB = hiA[g] * WB + hiB[g]; WA *= hiA[g]; }
            } else {
#pragma unroll
                for (int g = 3; g >= 0; --g) { WB = hiA[g] * WB + hiB[g]; WA *= hiA[g]; WB = loA[g] * WB + loB[g]; WA *= loA[g]; }
            }
            LAS float* WABw = (LAS float*)(lds + SC_WAB) + (ck & 1) * 512;
            if (hi == 0) { WABw[(w * 32 + n) * 2] = WA; WABw[(w * 32 + n) * 2 + 1] = WB; }
            if (DIR && VAR != 5) {
                *(LAS v4u*)(xb + lane * 16) = h0; *(LAS v4u*)(xb + 1024 + lane * 16) = h1;
#pragma unroll
                for (int q = 0; q < 16; ++q) hg2[q] = (unsigned)*(const LAS unsigned short*)(xb + ((q & 3) + 8 * (q >> 2) + 4 * hi) * 64 + n * 2);
                *(LAS v4u*)(xb + lane * 16) = g0; *(LAS v4u*)(xb + 1024 + lane * 16) = g1;
#pragma unroll
                for (int q = 0; q < 16; ++q) hg2[q] |= (unsigned)*(const LAS unsigned short*)(xb + ((q & 3) + 8 * (q >> 2) + 4 * hi) * 64 + n * 2) << 16;
            }
        }
    }
#undef SC_LOAD
#undef SC_WRITE
}
template <int VAR> __device__ __forceinline__ void scan_item(Frame& F, int item, bf16* HGdst) {
    const int b = item >> 5, blk = (item >> 1) & 15, half = item & 1;
    scan_sweep<0, VAR>(F, b, blk, half, HGdst);
    scan_sweep<1, VAR>(F, b, blk, half, HGdst);
    __syncthreads();
}


struct Args { const float* in[23]; float* out; unsigned char* ws; int ph_lo, ph_hi, li, pad; };
__global__ void __launch_bounds__(NWAVES * 64, 2) skel_fwd(Args args) {
    extern __shared__ __attribute__((aligned(16))) unsigned char lds[];
    Frame F;
    F.lds = (LAS unsigned char*)lds;
    F.MISC = (volatile LAS unsigned*)(F.lds + MISC_OFF);
    F.wave = __builtin_amdgcn_readfirstlane((int)threadIdx.x >> 6); F.lane = lane_id_fresh(); F.tid = F.wave * 64 + F.lane;
    F.G = gridDim.x; { const int bx = blockIdx.x; F.vcu = (F.G % 8 == 0) ? (bx % 8) * (F.G / 8) + bx / 8 : bx; }
#define FILL_FRAME() do { F.lane = lane_id_fresh(); F.tid = F.wave * 64 + F.lane; const __attribute__((address_space(4))) Args* ap_ = (const __attribute__((address_space(4))) Args*)__builtin_amdgcn_kernarg_segment_ptr(); asm volatile("" : "+s"(ap_)); \
    unsigned char* ws = ap_->ws; \
    F.ctl = (gu32*)(ws + WS_CTL); \
    F.x = ap_->in[0]; F.norm1_g = ap_->in[1]; F.w_in = ap_->in[2]; F.conv_w = ap_->in[3]; F.conv_b = ap_->in[4]; F.wa_f = ap_->in[5]; F.ba_f = ap_->in[6]; F.wx_f = ap_->in[7]; F.bx_f = ap_->in[8]; F.lam_f = ap_->in[9]; \
    F.wa_b = ap_->in[10]; F.ba_b = ap_->in[11]; F.wx_b = ap_->in[12]; F.bx_b = ap_->in[13]; F.lam_b = ap_->in[14]; F.q_norm_g = ap_->in[15]; F.k_norm_g = ap_->in[16]; F.p_rnn = ap_->in[17]; F.p_attn = ap_->in[18]; \
    F.w_o = ap_->in[19]; F.norm2_g = ap_->in[20]; F.w_ffn_in = ap_->in[21]; F.w_ffn_out = ap_->in[22]; F.out = ap_->out; \
    F.Win_t = (bf16*)(ws + WS_WIN); F.Wpr_t = (bf16*)(ws + WS_WPR); F.Wpa_t = (bf16*)(ws + WS_WPA); F.Wo_t = (bf16*)(ws + WS_WO); F.Wfi_t = (bf16*)(ws + WS_WFI); F.Wfo_t = (bf16*)(ws + WS_WFO); \
    F.U = (bf16*)(ws + WS_U); F.RX = (bf16*)(ws + WS_RX); F.GG = (bf16*)(ws + WS_GG); F.Q = (bf16*)(ws + WS_Q); F.K = (bf16*)(ws + WS_K); F.V = (bf16*)(ws + WS_V); \
    F.SR = (bf16*)(ws + WS_SR); F.SA = (bf16*)(ws + WS_SA); F.HG = (bf16*)(ws + WS_U); F.MG = (bf16*)(ws + WS_RX); F.X1B = (bf16*)(ws + WS_U); F.Fb = (bf16*)(ws + WS_F); \
    F.ROPE = (float*)(ws + WS_ROPE); F.SSQ = (float*)(ws + WS_SSQ); F.SCB = (float*)(ws + WS_SCB); F.SCW = (bf16*)(ws + WS_SCW); \
    } while (0)
    unsigned char* ws = args.ws;
    F.ctl = (gu32*)(ws + WS_CTL);
    for (int u = F.tid; u < LDSCTL_BYTES / 4; u += NWAVES * 64) ((LAS unsigned*)(F.lds + LDSCTL_OFF))[u] = 0u;
    __syncthreads();
    XcdBarrier bar; bar.bar = (unsigned*)(F.ctl + CW_BAR); bar.x = 0; bar.st = nullptr;
    if (N_LAUNCHES != PER_PHASE) bar = xcd_barrier_post((unsigned*)(F.ctl + CW_BAR), F.MISC + 8);
#define GRID_BAR() do { if (N_LAUNCHES != PER_PHASE) xcd_barrier(bar); } while (0)
    const int lo = args.ph_lo, hi = args.ph_hi;
#define IN(k) (lo <= (k) && (k) < hi)
#define BOTH(k) (IN(k) && IN((k) + 1))

    if (IN(0) && !(DBG_SKIP & 1)) { FILL_FRAME();
#if DBG_P0VAR > 0
        if (args.pad) p0_prologue<DBG_P0VAR>(F); else
#endif
        p0_prologue<0>(F); if (BOTH(0)) GRID_BAR(); }

    if (IN(1) && !(DBG_SKIP & 2)) {
        FILL_FRAME();
        pg8::Gemm g{F.U, F.U, F.Win_t, F.Win_t, M, DIN, D}; pg8::StaticOrder S; S.init(M, DIN, F.G, (int)blockIdx.x, WGM_BIG);
        { LAS float* tl_ = (LAS float*)(F.lds + TAB_OFF);
          *(LAS f32x4*)(tl_ + 128 + 4 * F.tid) = *(const GAS f32x4*)(F.ROPE + 4 * F.tid);
          if (F.tid < 64) tl_[F.tid] = F.q_norm_g[F.tid]; else if (F.tid < 128) tl_[F.tid] = F.k_norm_g[F.tid - 64];
          __syncthreads(); }
        pg8::EpiProj E{F.RX, F.GG, F.Q, F.K, F.V, F.SR, F.SA, (const LAS float*)(F.lds + TAB_OFF), (const LAS float*)(F.lds + TAB_OFF) + 64, (const LAS float*)(F.lds + TAB_OFF) + 128};
        pg8::gemm_phase<pg8::EpiProj, pg8::StaticOrder, true, true>(F.lds + RING_OFF, g, S, E, DBG_EPI2 && args.pad != 0);
        if (BOTH(1)) GRID_BAR();
    }

    if (IN(2) && !(DBG_SKIP & 4)) {
        FILL_FRAME();
#if DBG_SCANVAR >= 0
        if (args.pad) { for (int it = F.vcu; it < 256; it += F.G) scan_item<DBG_SCANVAR>(F, it, (bf16*)F.out + (size_t)M * D); }
        else
#endif
        for (int it = F.vcu; it < 256; it += F.G) scan_item<0>(F, it, F.HG);
    }
    if (IN(3) && !(DBG_SKIP & 8)) {
        FILL_FRAME();
        const attn_body::AttnOrder S{F.vcu, F.G};
        int b, h, qb;
        for (int i = 0; S.next(i, b, h, qb); ++i)
            attn_body::attn_unit<8>(b, h, qb, (const attn_body::bf16*)F.Q, (const attn_body::bf16*)F.K, (const attn_body::bf16*)F.V, (attn_body::bf16*)F.Q, (char*)lds + RING_OFF);
        if (BOTH(3)) GRID_BAR();
    }

    if (IN(4) && !(DBG_SKIP & 16)) {
        FILL_FRAME();
        pg8::Gemm g{F.HG, F.Q, F.Wpr_t, F.Wpa_t, M, D, D}; pg8::PairOrder S; S.init(M, D, F.G, (int)blockIdx.x, WGM_SMALL);
        pg8::EpiMerge E{F.SR, F.SA, F.MG};
        pg8::gemm_phase<pg8::EpiMerge, pg8::PairOrder, true, true>(F.lds + RING_OFF, g, S, E);
        if (BOTH(4)) GRID_BAR();
    }

    if (IN(5) && !(DBG_SKIP & 32)) {
        FILL_FRAME();
        pg8::Gemm g{F.MG, F.MG, F.Wo_t, F.Wo_t, M, D, D}; pg8::StaticOrder S; S.init(M, D, F.G, (int)blockIdx.x, WGM_SMALL);
        pg8::EpiX1 E{F.x, F.X1B, F.SSQ};
        pg8::gemm_phase<pg8::EpiX1, pg8::StaticOrder, true, true>(F.lds + RING_OFF, g, S, E);
        if (BOTH(5)) GRID_BAR();
    }

    if (IN(6) && !(DBG_SKIP & 64)) {
        FILL_FRAME();
        pg8::Gemm g{F.X1B, F.X1B, F.Wfi_t, F.Wfi_t, M, DIN, D}; pg8::StaticOrder S; S.init(M, DIN, F.G, (int)blockIdx.x, WGM_BIG);
        pg8::EpiFfn E{F.SSQ, F.Fb};
        pg8::gemm_phase<pg8::EpiFfn, pg8::StaticOrder, true, true>(F.lds + RING_OFF, g, S, E, DBG_EPI2 && args.pad != 0);
        if (BOTH(6)) GRID_BAR();
    }

    if (IN(7) && !(DBG_SKIP & 128)) {
        FILL_FRAME();
        pg8::Gemm g{F.Fb, F.Fb, F.Wfo_t, F.Wfo_t, M, D, DFF}; pg8::StaticOrder S; S.init(M, D, F.G, (int)blockIdx.x, WGM_SMALL);
        pg8::EpiOut E{F.X1B, F.out};
        pg8::gemm_phase<pg8::EpiOut, pg8::StaticOrder, true, true>(F.lds + RING_OFF, g, S, E, DBG_EPI2 && args.pad != 0);
    }
#undef IN
#undef BOTH
}


#ifndef DBG_STOP
#define DBG_STOP 0
#endif
#if DBG_STOP
__global__ void dbg_dump(float* out, const unsigned char* ws, int stop) {
    const size_t i = (size_t)blockIdx.x * blockDim.x + threadIdx.x;
    const size_t row = i >> 10, col = i & 1023;
    auto bf = [](const unsigned char* p, size_t idx) { return __uint_as_float((unsigned)((const unsigned short*)p)[idx] << 16); };
    float v = 0.f;
    if (stop == 1) { v = bf(ws + WS_U, i) + 3.f * bf(ws + WS_WIN, i) + 5.f * bf(ws + WS_WFI, i) + 7.f * bf(ws + WS_WPR, i & 1048575) + 11.f * bf(ws + WS_WPA, i & 1048575) + 13.f * bf(ws + WS_WO, i & 1048575) + 17.f * bf(ws + WS_WFO, i % (1024 * 2816)) + ((const float*)(ws + WS_ROPE))[i & 2047]; }
    if (stop == 2) { v = bf(ws + WS_Q, i) + 3.f * bf(ws + WS_GG, i) + 5.f * bf(ws + WS_RX, i) + 7.f * bf(ws + WS_SR, i) + 11.f * bf(ws + WS_SA, i); if (col < 256) v += 13.f * bf(ws + WS_K, row * 256 + col) + 17.f * bf(ws + WS_V, row * 256 + col); }
    if (stop == 3) { v = bf(ws + WS_Q, i) + 3.f * bf(ws + WS_GG, i); }
    if (stop == 31) { v = bf(ws + WS_Q, i); }
    if (stop == 32) { v = bf(ws + WS_GG, i); }
    if (stop == 4) { v = bf(ws + WS_U, i); }
    if (stop == 5) { v = out[i] + 3.f * bf(ws + WS_RX, i) + ((const float*)(ws + WS_SSQ))[i & (32768 * 16 - 1)]; }
    if (stop == 6) { v = bf(ws + WS_F, i) + bf(ws + WS_F, i + (size_t)32768 * 1024) + ((i + (size_t)2 * 32768 * 1024) < (size_t)32768 * 2816 ? bf(ws + WS_F, i + (size_t)2 * 32768 * 1024) : 0.f); }
    out[i] = v;
}
#endif
extern "C" void kernel_launch(void* const* d_in, const int* in_sizes, int n_in, void* d_out, int out_size, void* d_ws, size_t ws_size, hipStream_t stream) {
    static int grid = 0;
    if (grid == 0) {
        if (n_in != 23 || in_sizes[0] != M * D || out_size != M * D || ws_size < WS_END) { fprintf(stderr, "kernel_launch: unexpected shapes (n_in %d, in0 %d, out %d, ws %zu); nothing launched\n", n_in, n_in > 0 ? in_sizes[0] : -1, out_size, ws_size); grid = -1; return; }
        int dev = 0, cus = 0, per_cu = 0;
        if (hipGetDevice(&dev) != hipSuccess || hipDeviceGetAttribute(&cus, hipDeviceAttributeMultiprocessorCount, dev) != hipSuccess) { fprintf(stderr, "kernel_launch: device query failed\n"); grid = -1; return; }
        if (hipFuncSetAttribute((const void*)skel_fwd, hipFuncAttributeMaxDynamicSharedMemorySize, LDS_BYTES) != hipSuccess) { fprintf(stderr, "kernel_launch: hipFuncSetAttribute failed\n"); grid = -1; return; }
        if (hipOccupancyMaxActiveBlocksPerMultiprocessor(&per_cu, (const void*)skel_fwd, NWAVES * 64, LDS_BYTES) != hipSuccess || per_cu < 1) { fprintf(stderr, "kernel_launch: occupancy query reports %d workgroups per CU\n", per_cu); }
        (void)hipGetLastError();
        grid = cus;
    }
    if (grid < 0) return;
    if (hipMemsetAsync((char*)d_ws + WS_CTL, 0, CTL_ZERO_BYTES, stream) != hipSuccess) { fprintf(stderr, "kernel_launch: hipMemsetAsync failed\n"); return; }
    Args a{};
    for (int i = 0; i < 23; ++i) a.in[i] = (const float*)d_in[i];
    a.out = (float*)d_out; a.ws = (unsigned char*)d_ws;
    for (int li = 0; li < N_LAUNCHES; ++li) {
#if DBG_STOP
        if (li >= (DBG_STOP > 10 ? DBG_STOP / 10 : DBG_STOP)) break;
#endif
        a.ph_lo = (N_LAUNCHES == PER_PHASE) ? li : 0; a.ph_hi = (N_LAUNCHES == PER_PHASE) ? li + 1 : PER_PHASE; a.li = li;
        hipLaunchKernelGGL(skel_fwd, dim3(grid), dim3(NWAVES * 64), LDS_BYTES, stream, a);
        if (N_LAUNCHES == PER_PHASE && ((DBG_REPEAT >> li) & 1) && li != 3) { if ((li == 2 && DBG_SCANVAR >= 0) || DBG_EPI2 || (li == 0 && DBG_P0VAR > 0)) a.pad = 1; hipLaunchKernelGGL(skel_fwd, dim3(grid), dim3(NWAVES * 64), LDS_BYTES, stream, a); a.pad = 0; }
        const hipError_t le = hipPeekAtLastError();
        if (le != hipSuccess) { fprintf(stderr, "kernel_launch: launch %d failed: %s\n", li, hipGetErrorName(le)); break; }
    }
    if (N_LAUNCHES == PER_PHASE && (DBG_REPEAT & 256)) for (int li = 5; li < 8; ++li) { a.ph_lo = li; a.ph_hi = li + 1; a.li = li; hipLaunchKernelGGL(skel_fwd, dim3(grid), dim3(NWAVES * 64), LDS_BYTES, stream, a); }
#if DBG_STOP
    hipLaunchKernelGGL(dbg_dump, dim3(M * D / 256), dim3(256), 0, stream, (float*)d_out, (const unsigned char*)d_ws, (int)DBG_STOP);
#endif
}
```

```cpp
#include <hip/hip_runtime.h>
#include <hip/hip_bf16.h>
#include <cstdio>
#include <cstdint>
#include <cmath>

#ifndef DBG_EPI2
#define DBG_EPI2 0
#endif
#ifndef RELAX_EPI
#define RELAX_EPI 1
#endif
#ifndef WGM_BIG
#define WGM_BIG 8
#endif
#ifndef WGM_SMALL
#define WGM_SMALL 8
#endif
#ifndef PN_ROT
#define PN_ROT 1
#endif
#ifndef MK_N_LAUNCHES
#define MK_N_LAUNCHES 1
#endif

__device__ __forceinline__ int lane_id_fresh() { int l; asm volatile("v_mbcnt_lo_u32_b32 %0, -1, 0\n\tv_mbcnt_hi_u32_b32 %0, -1, %0" : "=v"(l)); return l; }

namespace pg8 {
#define PG8_LAS __attribute__((address_space(3)))
typedef unsigned short bf16_t;
typedef short bf16x8 __attribute__((ext_vector_type(8)));
typedef float f32x4 __attribute__((ext_vector_type(4)));
typedef unsigned u32x4 __attribute__((ext_vector_type(4)));
typedef unsigned u32x2 __attribute__((ext_vector_type(2)));
constexpr int BM = 256, BK = 64, HALF = 128, HTB = HALF * BK * 2  , STAGE_BYTES = 8 * HTB, NXCD = 8;

__host__ __device__ __forceinline__ int lds_byte(int r, int c) { const int st = (r >> 4) * 2 + (c >> 5), rr = r & 15, cc = c & 31, ob = rr * 64 + cc * 2; return st * 1024 + (ob ^ (((ob >> 9) & 1) << 5)); }
__host__ __device__ __forceinline__ void stage_rc(int b, int& R, int& C) { const int st = b / 1024, sb = b % 1024, swz = sb ^ (((sb >> 9) & 1) << 5); R = (st >> 1) * 16 + swz / 64; C = (st & 1) * 32 + (swz % 64) / 2; }
__host__ __device__ __forceinline__ int perm32(int rho) { const int n = rho >> 4, i = rho & 15; return 8 * (i >> 2) + 4 * n + (i & 3); }

struct Unit { int pm, pn, z; };
constexpr size_t FPANEL = (size_t)32 << 20;
struct Gemm { const bf16_t *A0, *A1, *B0, *B1; int M, N, K; int lda = 0; size_t padj = 0; };

struct StaticOrder {
    int nM, nN, nwg, G, c, wgm;
    __host__ __device__ void init(int M, int N, int G_, int c_, int wgm_) { nM = M / BM; nN = N / BM; nwg = nM * nN; G = G_; c = c_; wgm = wgm_; }
    __host__ __device__ bool next(int i, Unit& u) const {
        const long L = (long)i * G + c; if (L >= nwg) return false;
        int wgid = (int)L; { const int q = nwg / NXCD, r = nwg % NXCD, xcd = wgid % NXCD, off = wgid / NXCD; wgid = (xcd < r ? xcd * (q + 1) : r * (q + 1) + (xcd - r) * q) + off; }
        const int nig = wgm * nN, gid = wgid / nig, fm = gid * wgm, gsz = (nM - fm) < wgm ? (nM - fm) : wgm;
        u.pm = fm + ((wgid % nig) % gsz); u.pn = (wgid % nig) / gsz; u.z = 0;
#if PN_ROT
        u.pn = (u.pn + (c & 7) * (nN > 8 ? 3 : 1)) % nN;
#endif
        return true;
    }
    __device__ __forceinline__ void a_ready(const Unit&) const {}
    __device__ __forceinline__ void done(const Unit&) const {}
};
struct PairOrder : StaticOrder {
    __host__ __device__ bool next(int i, Unit& u) const { const bool ok = StaticOrder::next(i >> 1, u); u.z = i & 1; return ok; }
};

typedef float f32x2_t __attribute__((ext_vector_type(2))); typedef __bf16 bf16x2_t __attribute__((ext_vector_type(2)));
__device__ __forceinline__ unsigned cvt_pk_bf16(float lo, float hi) { f32x2_t v = {lo, hi}; bf16x2_t b = __builtin_convertvector(v, bf16x2_t); return __builtin_bit_cast(unsigned, b); }
__device__ __forceinline__ float bf_lo(unsigned w) { return __uint_as_float(w << 16); }
__device__ __forceinline__ float bf_hi(unsigned w) { return __uint_as_float(w & 0xffff0000u); }
__device__ __forceinline__ float sigmoid_f(float v) { return __builtin_amdgcn_rcpf(1.0f + __builtin_amdgcn_exp2f(-1.4426950408889634f * v)); }
__device__ __forceinline__ float gelu_tanh_f(float v) { const float z = v * __builtin_fmaf(v * v, -2.302208198f * 0.044715f, -2.302208198f); return v * __builtin_amdgcn_rcpf(1.0f + __builtin_amdgcn_exp2f(z)); }
__device__ __forceinline__ u32x4 pack8(f32x4 v0, f32x4 v1) { u32x4 w; w.x = cvt_pk_bf16(v0[0], v0[1]); w.y = cvt_pk_bf16(v0[2], v0[3]); w.z = cvt_pk_bf16(v1[0], v1[1]); w.w = cvt_pk_bf16(v1[2], v1[3]); return w; }
constexpr float NORM_EPS = 1e-6f;
constexpr float ATT_C2 = 0.125f * 1.4426950408889634f;

struct EpiProj {
    static constexpr bool PERM = true, AFTER_DRAIN = false; static constexpr int NST = 16;
    __device__ __forceinline__ bool relax_ok(const Unit&, int ui) const { return ui > 0; }
    bf16_t *RX, *GG, *Q, *K, *V, *SR, *SA; const PG8_LAS float *gq, *gk; const PG8_LAS float* rope;
    __device__ __forceinline__ bool keep(const Unit&) const { return false; }
    template <int ACT> __device__ __forceinline__ void ew(f32x4 (&acc)[2][2][4][2], bf16_t* base, int ldc, int row0, int col0) const {
#pragma unroll
        for (int ai = 0; ai < 2; ++ai)
#pragma unroll
            for (int m = 0; m < 4; ++m) { bf16_t* rowp = base + (size_t)(row0 + ai * HALF + m * 16) * ldc + col0;
#pragma unroll
                for (int bj = 0; bj < 2; ++bj) { f32x4 v0 = acc[ai][bj][m][0], v1 = acc[ai][bj][m][1];
                    if (ACT == 1) {
#pragma unroll
                        for (int j = 0; j < 4; ++j) { v0[j] = gelu_tanh_f(v0[j]); v1[j] = gelu_tanh_f(v1[j]); } }
                    if (ACT == 2) {
#pragma unroll
                        for (int j = 0; j < 4; ++j) { v0[j] = 1.0f + __builtin_amdgcn_exp2f(v0[j]); v1[j] = 1.0f + __builtin_amdgcn_exp2f(v1[j]); } }
                    *(u32x4*)(rowp + bj * HALF) = pack8(v0, v1); }
                asm volatile("" ::: "memory"); }
    }
    __device__ __forceinline__ void vstore(f32x4 (&acc)[2][2][4][2], int row0, int wc, int fq) const {
#pragma unroll
        for (int ai = 0; ai < 2; ++ai)
#pragma unroll
            for (int m = 0; m < 4; ++m) { const int row = row0 + ai * HALF + m * 16, s = row & 4095;
#pragma unroll
                for (int bj = 0; bj < 2; ++bj)
                    *(u32x4*)(V + ((size_t)((((row >> 12) * 4 + 2 * bj + (wc >> 1)) * 64 + (s >> 6)) * 2 + (wc & 1)) * 64 + (s & 63)) * 32 + 8 * fq) = pack8(acc[ai][bj][m][0], acc[ai][bj][m][1]);
                asm volatile("" ::: "memory"); }
    }
    __device__ __forceinline__ void heads(f32x4 (&acc)[2][2][4][2], bf16_t* base, int ldc, int head, const PG8_LAS float* g, float scale, int row0, int fq) const {
        f32x4 gv[2][2];
#pragma unroll
        for (int bj = 0; bj < 2; ++bj)
#pragma unroll
            for (int n = 0; n < 2; ++n) gv[bj][n] = *(const PG8_LAS f32x4*)(g + 32 * bj + 8 * fq + 4 * n);
#pragma unroll
        for (int ai = 0; ai < 2; ++ai)
#pragma unroll
            for (int m = 0; m < 4; ++m) {
                const int row = row0 + ai * HALF + m * 16, s = row & 4095, rp = s >> 6, cp = s & 63;
                float ss = 0.f;
#pragma unroll
                for (int bj = 0; bj < 2; ++bj)
#pragma unroll
                    for (int n = 0; n < 2; ++n) { const f32x4 v = acc[ai][bj][m][n]; ss += (v[0] * v[0] + v[1] * v[1]) + (v[2] * v[2] + v[3] * v[3]); }
                ss += __shfl_xor(ss, 16); ss += __shfl_xor(ss, 32);
                const float rstd = __builtin_amdgcn_rsqf(ss * (1.0f / 64.0f) + NORM_EPS) * scale;
                bf16_t* rowp = base + (size_t)row * ldc + head * 64 + 8 * fq;
                if (ldc == 0) rowp = base + ((size_t)(((row >> 12) * 4 + head) * 64 + (s >> 6)) * 8 + fq) * 512 + (s & 63) * 8;
#pragma unroll
                for (int bj = 0; bj < 2; ++bj) {
                    const int pos = bj == 0 ? rp : cp;
                    const PG8_LAS f32x4* tp = (const PG8_LAS f32x4*)(rope + (pos * 16 + 4 * fq) * 2);
                    const f32x4 t0 = tp[0], t1 = tp[1];
                    f32x4 o[2];
#pragma unroll
                    for (int n = 0; n < 2; ++n) { const f32x4 v = acc[ai][bj][m][n] * gv[bj][n] * rstd; const f32x4 t = n ? t1 : t0;
                        o[n] = (f32x4){v[0] * t[0] - v[1] * t[1], v[0] * t[1] + v[1] * t[0], v[2] * t[2] - v[3] * t[3], v[2] * t[3] + v[3] * t[2]}; }
                    *(u32x4*)(rowp + (ldc == 0 ? 2048 : 32) * bj) = pack8(o[0], o[1]); }
                asm volatile("" ::: "memory");
            }
    }
    __device__ __forceinline__ void operator()(f32x4 (&acc)[2][2][4][2], const Unit& u, int wr, int wc, int fr, int fq) const {
        const int pn = u.pn, row0 = u.pm * BM + wr * 64 + fr, cpos = wc * 32 + 8 * fq;
        if (pn >= 8 && pn <= 12) { const bool isk = pn == 12; heads(acc, isk ? K : Q, isk ? 0 : 1024, isk ? wc : 4 * (pn - 8) + wc, isk ? gk : gq, isk ? 1.0f : ATT_C2, row0, fq); }
        else {
            if (pn == 13) { vstore(acc, row0, wc, fq); return; }
            bf16_t* base = pn < 4 ? RX : pn < 8 ? GG : pn == 13 ? V : pn < 18 ? SR : SA;
            const int ldc = pn == 13 ? 256 : 1024, ct = pn < 4 ? pn : pn < 8 ? pn - 4 : pn == 13 ? 0 : pn < 18 ? pn - 14 : pn - 18;
            if (pn < 4 || pn == 13) ew<0>(acc, base, ldc, row0, ct * 256 + cpos);
            else if (pn < 8) ew<1>(acc, base, ldc, row0, ct * 256 + cpos);
            else ew<2>(acc, base, ldc, row0, ct * 256 + cpos);
        }
    }
};

struct EpiMerge {
    static constexpr bool PERM = true, AFTER_DRAIN = false; static constexpr int NST = 16;
    __device__ __forceinline__ bool relax_ok(const Unit& u, int ui) const { return ui > 0 && u.z == 0; }
    const bf16_t *SR, *SA; bf16_t* MG;
    __device__ __forceinline__ bool keep(const Unit& u) const { return u.z == 0; }
    __device__ __forceinline__ void operator()(f32x4 (&acc)[2][2][4][2], const Unit& u, int wr, int wc, int fr, int fq) const {
        const int row0 = u.pm * BM + wr * 64 + fr, col0 = u.pn * BM + wc * 32 + 8 * fq;
#pragma unroll
        for (int ai = 0; ai < 2; ++ai) {
            u32x4 wa[4][2], ws[4][2];
#pragma unroll
            for (int m = 0; m < 4; ++m)
#pragma unroll
                for (int bj = 0; bj < 2; ++bj) { const size_t off = (size_t)(row0 + ai * HALF + m * 16) * 1024 + col0 + bj * HALF;
                    wa[m][bj] = *(const u32x4*)(SA + off); if (u.z == 0) ws[m][bj] = *(const u32x4*)(SR + off); }
            asm volatile("" ::: "memory");
#pragma unroll
            for (int m = 0; m < 4; ++m)
#pragma unroll
                for (int bj = 0; bj < 2; ++bj) { const size_t off = (size_t)(row0 + ai * HALF + m * 16) * 1024 + col0 + bj * HALF;
                    const u32x4 a = wa[m][bj];
                    float da[8] = {bf_lo(a.x), bf_hi(a.x), bf_lo(a.y), bf_hi(a.y), bf_lo(a.z), bf_hi(a.z), bf_lo(a.w), bf_hi(a.w)};
#pragma unroll
                    for (int j = 0; j < 8; ++j) da[j] = fminf(da[j], 1e30f);
                    if (u.z == 0) {
                        const u32x4 s = ws[m][bj];
                        const float dr[8] = {bf_lo(s.x), bf_hi(s.x), bf_lo(s.y), bf_hi(s.y), bf_lo(s.z), bf_hi(s.z), bf_lo(s.w), bf_hi(s.w)};
#pragma unroll
                        for (int j = 0; j < 4; ++j) { acc[ai][bj][m][0][j] *= da[j] * __builtin_amdgcn_rcpf(dr[j]); acc[ai][bj][m][1][j] *= da[4 + j] * __builtin_amdgcn_rcpf(dr[4 + j]); }
                    } else {
                        f32x4 v0 = acc[ai][bj][m][0], v1 = acc[ai][bj][m][1];
#pragma unroll
                        for (int j = 0; j < 4; ++j) { v0[j] *= __builtin_amdgcn_rcpf(da[j]); v1[j] *= __builtin_amdgcn_rcpf(da[4 + j]); }
                        *(u32x4*)(MG + off) = pack8(v0, v1);
                    } }
        }
    }
};

struct EpiX1 {
    static constexpr bool PERM = true, AFTER_DRAIN = false; static constexpr int NST = 24;
    __device__ __forceinline__ bool relax_ok(const Unit&, int ui) const { return ui > 0; }
    const float* x; bf16_t* X1B; float* SSQ;
    __device__ __forceinline__ bool keep(const Unit&) const { return false; }
    __device__ __forceinline__ void ld(f32x4 (&xv)[2][2][2], int r, int row0, int col0) const {
#pragma unroll
        for (int mm = 0; mm < 2; ++mm)
#pragma unroll
            for (int bj = 0; bj < 2; ++bj)
#pragma unroll
                for (int n = 0; n < 2; ++n) xv[mm][bj][n] = *(const f32x4*)(x + (size_t)(row0 + (r >> 1) * HALF + (2 * (r & 1) + mm) * 16) * 1024 + col0 + bj * HALF + n * 4);
    }
    __device__ __forceinline__ void add(f32x4 (&acc)[2][2][4][2], const f32x4 (&xv)[2][2][2], int r) const {
#pragma unroll
        for (int mm = 0; mm < 2; ++mm)
#pragma unroll
            for (int bj = 0; bj < 2; ++bj)
#pragma unroll
                for (int n = 0; n < 2; ++n) acc[r >> 1][bj][2 * (r & 1) + mm][n] += xv[mm][bj][n];
    }
    __device__ __forceinline__ void st(const f32x4 (&acc)[2][2][4][2], int r, int row0, int col0, int pn, int wc, int fq) const {
        const int ai = r >> 1;
#pragma unroll
        for (int mm = 0; mm < 2; ++mm) { const int m = 2 * (r & 1) + mm, row = row0 + ai * HALF + m * 16; float s = 0.f;
#pragma unroll
            for (int bj = 0; bj < 2; ++bj) { const f32x4 o0 = acc[ai][bj][m][0], o1 = acc[ai][bj][m][1];
                s += ((o0[0] * o0[0] + o0[1] * o0[1]) + (o0[2] * o0[2] + o0[3] * o0[3])) + ((o1[0] * o1[0] + o1[1] * o1[1]) + (o1[2] * o1[2] + o1[3] * o1[3]));
                *(u32x4*)(X1B + (size_t)row * 1024 + col0 + bj * HALF) = pack8(o0, o1); }
            s += __shfl_xor(s, 16); s += __shfl_xor(s, 32);
            if (fq == 0) SSQ[(size_t)row * 16 + pn * 4 + wc] = s; }
    }
    __device__ __forceinline__ void operator()(f32x4 (&acc)[2][2][4][2], const Unit& u, int wr, int wc, int fr, int fq) const {
        const int row0 = u.pm * BM + wr * 64 + fr, col0 = u.pn * BM + wc * 32 + 8 * fq;
        f32x4 xv[2][2][2];
        ld(xv, 0, row0, col0);
#pragma unroll
        for (int r = 0; r < 4; ++r) {
            asm volatile("" ::: "memory");
            add(acc, xv, r);
            asm volatile("" ::: "memory");
            if (r < 3) ld(xv, r + 1, row0, col0);
            asm volatile("" ::: "memory");
            st(acc, r, row0, col0, u.pn, wc, fq);
        }
    }
};

struct EpiFfn {
    static constexpr bool PERM = true, AFTER_DRAIN = false; static constexpr int NST = 8;
    __device__ __forceinline__ bool relax_ok(const Unit&, int ui) const { return ui > 0; }
    const float* SSQ; bf16_t* F;
    mutable int pmc = -1; mutable float rsc[2][4];
    __device__ __forceinline__ bool keep(const Unit&) const { return false; }
    __device__ __forceinline__ void operator()(f32x4 (&acc)[2][2][4][2], const Unit& u, int wr, int wc, int fr, int fq) const {
        const int row0 = u.pm * BM + wr * 64 + fr, colf = u.pn * HALF + wc * 32 + 8 * fq;
        if (u.pm != pmc) { pmc = u.pm;
        f32x4 sp[2][4];
#pragma unroll
        for (int ai = 0; ai < 2; ++ai)
#pragma unroll
            for (int m = 0; m < 4; ++m) sp[ai][m] = *(const f32x4*)(SSQ + (size_t)(row0 + ai * HALF + m * 16) * 16 + 4 * fq);
        asm volatile("" ::: "memory");
        float rs[2][4];
#pragma unroll
        for (int ai = 0; ai < 2; ++ai)
#pragma unroll
            for (int m = 0; m < 4; ++m) { float tot = (sp[ai][m][0] + sp[ai][m][1]) + (sp[ai][m][2] + sp[ai][m][3]);
                tot += __shfl_xor(tot, 16); tot += __shfl_xor(tot, 32);
                rs[ai][m] = __builtin_amdgcn_rsqf(tot * (1.0f / 1024.0f) + NORM_EPS); }
        asm volatile("" : "+v"(rs[0][0]), "+v"(rs[0][1]), "+v"(rs[0][2]), "+v"(rs[0][3]), "+v"(rs[1][0]), "+v"(rs[1][1]), "+v"(rs[1][2]), "+v"(rs[1][3]));
#pragma unroll
        for (int ai = 0; ai < 2; ++ai)
#pragma unroll
            for (int m = 0; m < 4; ++m) rsc[ai][m] = rs[ai][m];
        }
#pragma unroll
        for (int ai = 0; ai < 2; ++ai)
#pragma unroll
            for (int m = 0; m < 4; ++m) { const int row = row0 + ai * HALF + m * 16;
                const float rstd = rsc[ai][m], r2 = rstd * rstd, rl = rstd * -1.4426950408889634f;
                f32x4 o[2];
#pragma unroll
                for (int n = 0; n < 2; ++n) { const f32x4 a = acc[ai][0][m][n], up = acc[ai][1][m][n];
#pragma unroll
                    for (int j = 0; j < 4; ++j) o[n][j] = (a[j] * up[j]) * r2 * __builtin_amdgcn_rcpf(1.0f + __builtin_amdgcn_exp2f(a[j] * rl)); }
                *(u32x4*)(F + (size_t)(colf >> 10) * FPANEL + (size_t)row * 1024 + (colf & 1023)) = pack8(o[0], o[1]); }
    }
};

struct EpiOut {
    static constexpr bool PERM = true, AFTER_DRAIN = false; static constexpr int NST = 32;
    __device__ __forceinline__ bool relax_ok(const Unit&, int ui) const { return ui > 0; }
    const bf16_t* X1B; float* out;
    __device__ __forceinline__ bool keep(const Unit&) const { return false; }
    __device__ __forceinline__ void operator()(f32x4 (&acc)[2][2][4][2], const Unit& u, int wr, int wc, int fr, int fq) const {
        const int row0 = u.pm * BM + wr * 64 + fr, col0 = u.pn * BM + wc * 32 + 8 * fq;
        u32x4 xv[2][4][2];
#pragma unroll
        for (int ai = 0; ai < 2; ++ai)
#pragma unroll
            for (int m = 0; m < 4; ++m)
#pragma unroll
                for (int bj = 0; bj < 2; ++bj) xv[ai][m][bj] = *(const u32x4*)(X1B + (size_t)(row0 + ai * HALF + m * 16) * 1024 + col0 + bj * HALF);
        asm volatile("" ::: "memory");
#pragma unroll
        for (int ai = 0; ai < 2; ++ai)
#pragma unroll
            for (int m = 0; m < 4; ++m)
#pragma unroll
                for (int bj = 0; bj < 2; ++bj) { const u32x4 w = xv[ai][m][bj]; float* op = out + (size_t)(row0 + ai * HALF + m * 16) * 1024 + col0 + bj * HALF;
                    *(f32x4*)op = (f32x4){bf_lo(w.x), bf_hi(w.x), bf_lo(w.y), bf_hi(w.y)} + acc[ai][bj][m][0];
                    *(f32x4*)(op + 4) = (f32x4){bf_lo(w.z), bf_hi(w.z), bf_lo(w.w), bf_hi(w.w)} + acc[ai][bj][m][1]; }
    }
};

template <class Epi, class Sched, bool ALIGN_EPI = false, bool SP2 = false>
__device__ __forceinline__ void gemm_phase(PG8_LAS unsigned char* lds, const Gemm g, const Sched& S, const Epi& E, bool dbg_twice = false) {
    const int wid = __builtin_amdgcn_readfirstlane((int)threadIdx.x >> 6), lane = lane_id_fresh(), tid = wid * 64 + lane,     wr = wid >> 2, wc = wid & 3, fr = lane & 15, fq = lane >> 4;
    const int K = g.K, nt = K / BK, lda = g.lda ? g.lda : K;
    unsigned voffA[2], voffB[2];
#pragma unroll
    for (int i = 0; i < 2; ++i) { int R, C; stage_rc(tid * 16 + i * 8192, R, C); const int Rb = Epi::PERM ? ((R & ~31) + perm32(R & 31)) : R;
        voffA[i] = (unsigned)(R * lda + C) * 2u; voffB[i] = (unsigned)(Rb * K + C) * 2u; }
    const size_t kstep = (size_t)(BK * 2);
    const size_t hstepB = (size_t)HALF * K * 2, hstepA = (size_t)HALF * lda * 2;
    const size_t tstepB = 2 * hstepB, tstepA = 2 * hstepA;
    const size_t padj = g.padj;
#define PG8_KOFF(t_) ((size_t)(t_) * kstep + (size_t)((t_) >> 4) * padj)
    const unsigned ldsw = (unsigned)wid * 1024u;
    const int aoff = lds_byte(wr * 64 + fr, fq * 8), boff = lds_byte(wc * 32 + fr, fq * 8);
#define PG8_SA(b, h) (((b) * 2 + (h)) * HTB)
#define PG8_SB(b, h) ((4 + (b) * 2 + (h)) * HTB)
#define PG8_STAGE(bufoff, gbase, voff) do { _Pragma("unroll") for (int _i = 0; _i < 2; ++_i) \
        __builtin_amdgcn_global_load_lds((const unsigned*)((const char*)(gbase) + (voff)[_i]), (PG8_LAS unsigned*)(lds + (bufoff) + ldsw + _i * 8192), 16, 0, 0); } while (0)
#define PG8_LDA(dst, b, h) do { _Pragma("unroll") for (int m = 0; m < 4; ++m) _Pragma("unroll") for (int k = 0; k < 2; ++k) dst[m][k] = *(const PG8_LAS bf16x8*)(lds + PG8_SA(b, h) + aoff + m * 2048 + k * 1024); } while (0)
#define PG8_LDB(dst, b, h) do { _Pragma("unroll") for (int n = 0; n < 2; ++n) _Pragma("unroll") for (int k = 0; k < 2; ++k) dst[n][k] = *(const PG8_LAS bf16x8*)(lds + PG8_SB(b, h) + boff + n * 2048 + k * 1024); } while (0)
#define PG8_MMA(ai, bj, At, Bt) do { __builtin_amdgcn_s_setprio(1); _Pragma("unroll") for (int m = 0; m < 4; ++m) _Pragma("unroll") for (int n = 0; n < 2; ++n) _Pragma("unroll") for (int k = 0; k < 2; ++k) \
        acc[ai][bj][m][n] = __builtin_amdgcn_mfma_f32_16x16x32_bf16(Bt[n][k], At[m][k], acc[ai][bj][m][n], 0, 0, 0); __builtin_amdgcn_s_setprio(0); } while (0)
#define PG8_WAIT_V(n) asm volatile("s_waitcnt vmcnt(" #n ")" ::: "memory")
#define PG8_WAIT_L(n) asm volatile("s_waitcnt lgkmcnt(" #n ")" ::: "memory")
#define PG8_WAIT_V8R_(n) asm volatile("s_cmp_eq_u32 %0, 0\n\ts_cbranch_scc1 .Lrlxn_%=\n\ts_waitcnt vmcnt(8)\n\ts_branch .Lrlxd_%=\n.Lrlxn_%=:\n\ts_waitcnt vmcnt(" #n ")\n.Lrlxd_%=:" :: "s"(rlx) : "scc", "memory")
#define PG8_WAIT_V8R() do { if constexpr (!RELAX_EPI) PG8_WAIT_V(8); else if constexpr (Epi::NST == 8) PG8_WAIT_V8R_(16); else if constexpr (Epi::NST == 16) PG8_WAIT_V8R_(24); else if constexpr (Epi::NST == 24) PG8_WAIT_V8R_(32); else if constexpr (Epi::NST == 32) PG8_WAIT_V8R_(40); else if constexpr (Epi::NST == 40) PG8_WAIT_V8R_(48); else PG8_WAIT_V(8); } while (0)
#define PG8_BAR __builtin_amdgcn_s_barrier()
#define PG8_SCHED __builtin_amdgcn_sched_barrier(0)
    Unit cur, nxt; int ui = 0;
    if (!S.next(0, cur)) return;
    f32x4 acc[2][2][4][2];
#pragma unroll
    for (int a = 0; a < 2; ++a)
#pragma unroll
        for (int b = 0; b < 2; ++b)
#pragma unroll
            for (int m = 0; m < 4; ++m)
#pragma unroll
                for (int n = 0; n < 2; ++n) acc[a][b][m][n] = (f32x4){0.f, 0.f, 0.f, 0.f};
    bf16x8 At[4][2], B0[2][2], B1[2][2];
    const char* cA = (const char*)(cur.z ? g.A1 : g.A0) + (size_t)cur.pm * tstepA; const char* cB = (const char*)(cur.z ? g.B1 : g.B0) + (size_t)cur.pn * tstepB;
    S.a_ready(cur);
    if constexpr (SP2) {
        PG8_STAGE(PG8_SB(0, 0), cB, voffB); PG8_STAGE(PG8_SB(0, 1), cB + hstepB, voffB); PG8_STAGE(PG8_SA(0, 0), cA, voffA); PG8_STAGE(PG8_SA(0, 1), cA + hstepA, voffA);
        if (wr == 1) PG8_BAR;
        PG8_WAIT_V(2); PG8_BAR;
        PG8_STAGE(PG8_SB(1, 0), cB + kstep, voffB); PG8_STAGE(PG8_SA(1, 0), cA + kstep, voffA); PG8_STAGE(PG8_SB(1, 1), cB + hstepB + kstep, voffB);
        PG8_WAIT_V(6); PG8_BAR;
    } else {
        PG8_STAGE(PG8_SB(0, 0), cB, voffB); PG8_STAGE(PG8_SA(0, 0), cA, voffA); PG8_STAGE(PG8_SB(0, 1), cB + hstepB, voffB); PG8_STAGE(PG8_SA(0, 1), cA + hstepA, voffA);
        if (wr == 1) PG8_BAR;
        PG8_WAIT_V(4); PG8_BAR;
        PG8_STAGE(PG8_SB(1, 0), cB + kstep, voffB); PG8_STAGE(PG8_SA(1, 0), cA + kstep, voffA); PG8_STAGE(PG8_SB(1, 1), cB + hstepB + kstep, voffB);
        PG8_WAIT_V(6); PG8_BAR;
    }
    for (;;) {
        const bool has_next = S.next(ui + 1, nxt);
        const char* nA = has_next ? (const char*)(nxt.z ? g.A1 : g.A0) + (size_t)nxt.pm * tstepA : cA; const char* nB = has_next ? (const char*)(nxt.z ? g.B1 : g.B0) + (size_t)nxt.pn * tstepB : cB;
        for (int t = 0; t < nt; t += 2) {
            const bool last = (t == nt - 2);
            const char* a1 = cA + PG8_KOFF(t + 1);
            const char* a2 = last ? nA : cA + PG8_KOFF(t + 2); const char* b2 = last ? nB : cB + (size_t)(t + 2) * kstep;
            const char* a3 = a2 + kstep; const char* b3 = b2 + kstep;
            if (last && has_next) S.a_ready(nxt);
            if constexpr (SP2) {
            const int rlx = __builtin_amdgcn_readfirstlane(t | (E.relax_ok(cur, ui) ? 0 : 1));
            PG8_LDB(B0, 0, 0); PG8_LDB(B1, 0, 1); PG8_SCHED; PG8_LDA(At, 0, 0); PG8_STAGE(PG8_SA(1, 1), a1 + hstepA, voffA);
            PG8_WAIT_V8R(); PG8_WAIT_L(0); PG8_BAR; PG8_MMA(0, 0, At, B0); PG8_MMA(0, 1, At, B1); PG8_BAR; PG8_SCHED;
            PG8_LDA(At, 0, 1); PG8_STAGE(PG8_SB(0, 0), b2, voffB); PG8_STAGE(PG8_SB(0, 1), b2 + hstepB, voffB); PG8_STAGE(PG8_SA(0, 0), a2, voffA);
            PG8_WAIT_V8R(); PG8_WAIT_L(0); PG8_BAR; PG8_MMA(1, 0, At, B0); PG8_MMA(1, 1, At, B1); PG8_BAR; PG8_SCHED;
            PG8_LDB(B0, 1, 0); PG8_LDB(B1, 1, 1); PG8_SCHED; PG8_LDA(At, 1, 0); PG8_STAGE(PG8_SA(0, 1), a2 + hstepA, voffA);
            PG8_WAIT_V(8); PG8_WAIT_L(0); PG8_BAR; PG8_MMA(0, 0, At, B0); PG8_MMA(0, 1, At, B1); PG8_BAR; PG8_SCHED;
            PG8_LDA(At, 1, 1); PG8_STAGE(PG8_SB(1, 0), b3, voffB); PG8_STAGE(PG8_SB(1, 1), b3 + hstepB, voffB); PG8_STAGE(PG8_SA(1, 0), a3, voffA);
            PG8_WAIT_V(8); PG8_WAIT_L(0); PG8_BAR; PG8_MMA(1, 0, At, B0); PG8_MMA(1, 1, At, B1); PG8_BAR; PG8_SCHED;
            } else {
            PG8_LDB(B0, 0, 0); PG8_SCHED; PG8_LDA(At, 0, 0); PG8_STAGE(PG8_SA(1, 1), a1 + hstepA, voffA);
            PG8_WAIT_L(8); PG8_BAR; PG8_WAIT_L(0); PG8_MMA(0, 0, At, B0); PG8_BAR; PG8_SCHED;
            PG8_LDB(B1, 0, 1); PG8_STAGE(PG8_SB(0, 0), b2, voffB);
            PG8_BAR; PG8_WAIT_L(0); PG8_MMA(0, 1, At, B1); PG8_BAR;
            PG8_LDA(At, 0, 1); PG8_STAGE(PG8_SA(0, 0), a2, voffA);
            PG8_BAR; PG8_WAIT_L(0); PG8_MMA(1, 0, At, B0); PG8_BAR; PG8_SCHED;
            PG8_STAGE(PG8_SB(0, 1), b2 + hstepB, voffB);
            PG8_WAIT_V(6); PG8_BAR; PG8_MMA(1, 1, At, B1); PG8_BAR;
            PG8_LDB(B0, 1, 0); PG8_SCHED; PG8_LDA(At, 1, 0); PG8_STAGE(PG8_SA(0, 1), a2 + hstepA, voffA);
            PG8_WAIT_L(8); PG8_BAR; PG8_WAIT_L(0); PG8_MMA(0, 0, At, B0); PG8_BAR; PG8_SCHED;
            PG8_LDB(B1, 1, 1); PG8_STAGE(PG8_SB(1, 0), b3, voffB);
            PG8_BAR; PG8_WAIT_L(0); PG8_MMA(0, 1, At, B1); PG8_BAR;
            PG8_LDA(At, 1, 1); PG8_STAGE(PG8_SA(1, 0), a3, voffA);
            PG8_BAR; PG8_WAIT_L(0); PG8_MMA(1, 0, At, B0); PG8_BAR; PG8_SCHED;
            PG8_STAGE(PG8_SB(1, 1), b3 + hstepB, voffB);
            PG8_WAIT_V(6); PG8_BAR; PG8_MMA(1, 1, At, B1); PG8_BAR;
            }
        }
        if constexpr (ALIGN_EPI) { if (wr == 0) PG8_BAR; }
        if constexpr (!Epi::AFTER_DRAIN) { int ln_ = lane; asm volatile("" : "+v"(ln_)); const int fr_ = ln_ & 15, fq_ = ln_ >> 4;
            E(acc, cur, wr, wc, fr_, fq_);
#if DBG_EPI2
            if (dbg_twice) { asm volatile("" ::: "memory"); E(acc, cur, wr, wc, fr_, fq_); }
#endif
            S.done(cur); }
        if (!has_next) break;
        if (!E.keep(cur)) {
#pragma unroll
        for (int a = 0; a < 2; ++a)
#pragma unroll
            for (int b = 0; b < 2; ++b)
#pragma unroll
                for (int m = 0; m < 4; ++m)
#pragma unroll
                    for (int n = 0; n < 2; ++n) acc[a][b][m][n] = (f32x4){0.f, 0.f, 0.f, 0.f};
        }
        cur = nxt; cA = nA; cB = nB; ++ui;
        if constexpr (ALIGN_EPI) { if (wr == 1) PG8_BAR; }
    }
    PG8_WAIT_V(0);
    if constexpr (!ALIGN_EPI) { if (wr == 0) PG8_BAR; }
    PG8_BAR;
    if constexpr (Epi::AFTER_DRAIN) { E.fused(acc, cur, wr, wc, fr, fq, lds, wid, lane); S.done(cur); }
#undef PG8_SA
#undef PG8_KOFF
#undef PG8_SB
#undef PG8_STAGE
#undef PG8_LDA
#undef PG8_LDB
#undef PG8_MMA
#undef PG8_WAIT_V
#undef PG8_WAIT_V8R
#undef PG8_WAIT_V8R_
#undef PG8_WAIT_L
#undef PG8_BAR
#undef PG8_SCHED
}
}

#include <hip/hip_bf16.h>
namespace attn_body {

using bf16=__hip_bfloat16;
using bf16x8=__attribute__((ext_vector_type(8)))short;
using s16x4=__attribute__((ext_vector_type(4)))short;
using f32x16=__attribute__((ext_vector_type(16)))float;
using u32x4=__attribute__((ext_vector_type(4)))unsigned;
constexpr int BATCH=8,NHEAD=16,SEQ=4096,D=64,DM=NHEAD*D,KVP=256;
constexpr int NW=8,QBLK=32,QB=QBLK*NW,KVBLK=64,NQB=SEQ/QB;
constexpr int ATTN_PITCH=DM, ATTN_UNIT_ROWS=QB;
__device__ __forceinline__ int crow(int r,int hi){return (r&3)+8*(r>>2)+4*hi;}
#define SBAR() __builtin_amdgcn_sched_barrier(0)
__device__ __forceinline__ void cmask(f32x16&p0,f32x16&p1,int jb,int qrel,int hi){
  const float NEG=-INFINITY; int kb=64*jb+4*hi;
  #pragma unroll
  for(int r=0;r<16;++r){int kv=kb+(r&3)+8*(r>>2); if(kv>qrel)p0[r]=NEG; if(kv+32>qrel)p1[r]=NEG;}
}

constexpr int NSLOT=3, SLOTB=8192;
constexpr int LDS_K=0, LDS_V=NSLOT*SLOTB, LDS_WS=2*NSLOT*SLOTB, LDS_OST=LDS_WS+NW*64*4, LDS_BYTES=LDS_OST+NW*4096;
constexpr float C2=0.125f*1.4426950408889634f;
__device__ __forceinline__ void glds16(const void*gsrc,unsigned lds_dst){unsigned keep;
  asm volatile("s_mov_b32 %0, m0\n\ts_mov_b32 m0, %2\n\ts_nop 0\n\tglobal_load_lds_dwordx4 %1, off\n\ts_mov_b32 m0, %0":"=&s"(keep):"v"(gsrc),"s"(lds_dst):"memory");}
__device__ __forceinline__ float max3f(float a,float b,float c){float r;asm("v_max3_f32 %0, %1, %2, %3":"=v"(r):"v"(a),"v"(b),"v"(c));return r;}
__device__ __forceinline__ float max2f(float a,float b){float r;asm("v_max_f32_e32 %0, %1, %2":"=v"(r):"v"(a),"v"(b));return r;}
__device__ __forceinline__ float fadd_s(float a,float b){float r;asm("v_add_f32_e32 %0, %1, %2":"=v"(r):"v"(a),"v"(b));return r;}
__device__ __forceinline__ float fsub_s(float a,float b){float r;asm("v_sub_f32_e32 %0, %1, %2":"=v"(r):"v"(a),"v"(b));return r;}
typedef float f32x2_t __attribute__((ext_vector_type(2))); typedef __bf16 bf16x2_t __attribute__((ext_vector_type(2)));
__device__ __forceinline__ unsigned cvtpk_s(float lo,float hi){f32x2_t v={lo,hi};bf16x2_t b=__builtin_convertvector(v,bf16x2_t);return __builtin_bit_cast(unsigned,b);}
#define WAIT_BAR(N) asm volatile("s_waitcnt vmcnt(" #N ") lgkmcnt(0)\n\ts_barrier":::"memory")

__device__ __forceinline__ void qkt(f32x16&p0,f32x16&p1,const char*Kslot,const bf16x8*qr,const f32x16&negm,int r32,int hi){
  const char*kb=Kslot+hi*1024+r32*16;
  #pragma unroll
  for(int d0=0;d0<4;++d0){
    const bf16x8 b0=*reinterpret_cast<const bf16x8*>(kb+d0*2048);
    const bf16x8 b1=*reinterpret_cast<const bf16x8*>(kb+d0*2048+512);
    if(d0==0){p0=__builtin_amdgcn_mfma_f32_32x32x16_bf16(b0,qr[0],negm,0,0,0);p1=__builtin_amdgcn_mfma_f32_32x32x16_bf16(b1,qr[0],negm,0,0,0);}
    else{p0=__builtin_amdgcn_mfma_f32_32x32x16_bf16(b0,qr[d0],p0,0,0,0);p1=__builtin_amdgcn_mfma_f32_32x32x16_bf16(b1,qr[d0],p1,0,0,0);}}
}
typedef __attribute__((address_space(3))) const char* lds_cptr;
typedef short v4i16_t __attribute__((ext_vector_type(4)));
__device__ __forceinline__ void kload8(bf16x8*kf,lds_cptr kp){
  kf[0]=*(const __attribute__((address_space(3))) bf16x8*)(kp);      kf[1]=*(const __attribute__((address_space(3))) bf16x8*)(kp+512);
  kf[2]=*(const __attribute__((address_space(3))) bf16x8*)(kp+2048); kf[3]=*(const __attribute__((address_space(3))) bf16x8*)(kp+2560);
  kf[4]=*(const __attribute__((address_space(3))) bf16x8*)(kp+4096); kf[5]=*(const __attribute__((address_space(3))) bf16x8*)(kp+4608);
  kf[6]=*(const __attribute__((address_space(3))) bf16x8*)(kp+6144); kf[7]=*(const __attribute__((address_space(3))) bf16x8*)(kp+6656);
}
__device__ __forceinline__ void kload2(bf16x8*kf,lds_cptr kp,int j){ kf[2*j]=*(const __attribute__((address_space(3))) bf16x8*)(kp+j*2048); kf[2*j+1]=*(const __attribute__((address_space(3))) bf16x8*)(kp+j*2048+512); }
__device__ __forceinline__ s16x4 vtr(lds_cptr p){ return __builtin_bit_cast(s16x4,__builtin_amdgcn_ds_read_tr16_b64_v4i16((__attribute__((address_space(3))) v4i16_t*)p)); }
__device__ __forceinline__ float rowmax(const f32x16&p0,const f32x16&p1){
  float a=max3f(p0[0],p0[1],p1[0]),b=max3f(p0[2],p0[3],p1[1]);a=max3f(a,p1[2],p1[3]);
  #pragma unroll
  for(int r=4;r<16;r+=4){a=max3f(a,p0[r],p0[r+1]);b=max3f(b,p0[r+2],p0[r+3]);a=max3f(a,p1[r],p1[r+1]);b=max3f(b,p1[r+2],p1[r+3]);}
  const float m=max2f(a,b);
  auto rr=__builtin_amdgcn_permlane32_swap(__float_as_uint(m),__float_as_uint(m),false,false);
  return max2f(__uint_as_float(rr[0]),__uint_as_float(rr[1]));
}
__device__ __forceinline__ void pv(f32x16*o,int vb,bf16x8 pa0,bf16x8 pa1,bf16x8 pa2,bf16x8 pa3){
  #pragma unroll
  for(int d0=0;d0<2;++d0){s16x4 lo[4],hi[4];
    #pragma unroll
    for(int ks=0;ks<4;++ks){
      asm volatile("ds_read_b64_tr_b16 %0,%1 offset:%c2":"=&v"(lo[ks]):"v"(vb),"i"(d0*4096+ks*1024):"memory");
      asm volatile("ds_read_b64_tr_b16 %0,%1 offset:%c2":"=&v"(hi[ks]):"v"(vb),"i"(d0*4096+ks*1024+512):"memory");}
    asm volatile("s_waitcnt lgkmcnt(0)":::"memory");SBAR();
    #define PK(k) (bf16x8){lo[k][0],lo[k][1],lo[k][2],lo[k][3],hi[k][0],hi[k][1],hi[k][2],hi[k][3]}
    o[d0]=__builtin_amdgcn_mfma_f32_32x32x16_bf16(pa0,PK(0),o[d0],0,0,0);
    o[d0]=__builtin_amdgcn_mfma_f32_32x32x16_bf16(pa1,PK(1),o[d0],0,0,0);
    o[d0]=__builtin_amdgcn_mfma_f32_32x32x16_bf16(pa2,PK(2),o[d0],0,0,0);
    o[d0]=__builtin_amdgcn_mfma_f32_32x32x16_bf16(pa3,PK(3),o[d0],0,0,0);
    #undef PK
  }
}

#ifndef ATTN_STORE16
#define ATTN_STORE16(p,v) (*(u32x4*)(p)=(v))
#endif
template<int THRL> __device__ __forceinline__ void attn_unit(int b,int h,int qb,const bf16*Q,const bf16*__restrict__ K,const bf16*__restrict__ V,bf16*O,char*shm,int nb,int nh,int nqb,bool has_next,bool first,bf16x8(&qr)[4]){
  const int wid=__builtin_amdgcn_readfirstlane((int)threadIdx.x>>6); const int lane=lane_id_fresh(),r32=lane&31,hi=lane>>5;
  const long rowbase=(long)b*SEQ; const int q0=qb*QB;
  const bf16*Qw=Q+(rowbase+q0+wid*QBLK)*DM+h*D;
  const bf16*Kh=K+(long)(b*4+(h>>2))*SEQ*D,*Vh=V+(long)(b*4+(h>>2))*SEQ*D;
  const unsigned lds0=(unsigned)(uintptr_t)shm;
  float*wsf=(float*)(shm+LDS_WS)+wid*64;
  const bf16*ksrc=Kh+(wid*64+lane)*8;
  const bf16*vsrc=Vh+((wid>>2)*64+16*(wid&3)+(lane>>2))*32+(lane&3)*8;
  const unsigned kdst=lds0+LDS_K+wid*1024, vdst=lds0+LDS_V+wid*1024;
  #define DMA_K(t,slot) glds16(ksrc+(long)(t)*KVBLK*D,(unsigned)__builtin_amdgcn_readfirstlane(kdst+(slot)))
  #define DMA_V(t,slot) glds16(vsrc+(long)(t)*KVBLK*D,(unsigned)__builtin_amdgcn_readfirstlane(vdst+(slot)))
  const int vb0=(int)(lds0+LDS_V)+((lane>>4)&1)*32+(lane&3)*8+(4*hi+((lane&15)>>2))*64;
  const char*Kbase=shm+LDS_K; bf16x8 kf[8];
  const lds_cptr shm3=(lds_cptr)shm; const lds_cptr kp0=shm3+LDS_K+hi*1024+r32*16; const lds_cptr vp0=shm3+LDS_V+((lane>>4)&1)*32+(lane&3)*8+(4*hi+((lane&15)>>2))*64;
  const int NT=SEQ/KVBLK;
  const bf16*Qw_n=Q+((long)nb*SEQ+nqb*QB+wid*QBLK)*DM+nh*D;
  const bf16*ksrc_n=K+(long)(nb*4+(nh>>2))*SEQ*D+(wid*64+lane)*8;
  const bf16*vsrc_n=V+(long)(nb*4+(nh>>2))*SEQ*D+((wid>>2)*64+16*(wid&3)+(lane>>2))*32+(lane&3)*8;
  if(first){DMA_K(0,0);DMA_V(0,0);DMA_K(1,SLOTB);}
  if(first){
  #pragma unroll
  for(int d0=0;d0<4;++d0)qr[d0]=*reinterpret_cast<const bf16x8*>(&Qw[(long)r32*DM+d0*16+hi*8]);}
  float l_reg=0.f;f32x16 o[2];o[0]=f32x16{};o[1]=f32x16{}; const f32x16 zz=f32x16{};

  #define CMASK(P0,P1,t) do{}while(0)
  f32x16 pA0,pA1,pB0,pB1;
  int sl_prev=0,sl_cur=0,sl_next=SLOTB;
  #define ROT() do{sl_prev=sl_cur;sl_cur=sl_next;sl_next=(sl_next==(NSLOT-1)*SLOTB)?0:sl_next+SLOTB;}while(0)
  if(first)DMA_K(2,2*SLOTB);
  WAIT_BAR(3);
  qkt(pA0,pA1,Kbase,qr,zz,r32,hi);
  _Pragma("unroll") for(int r=0;r<16;++r)pA0[r]=__builtin_amdgcn_exp2f(pA0[r]);
  _Pragma("unroll") for(int r=0;r<16;++r)pA1[r]=__builtin_amdgcn_exp2f(pA1[r]);
  WAIT_BAR(0);
  DMA_K(3,0);DMA_V(1,SLOTB);
  ROT();
  kload8(kf,kp0+sl_cur);
  WAIT_BAR(2);
  s16x4 vlo[8],vhi[8]; u32x4 pw0,pw1,pw2,pw3;
  #define PKW(P,B) cvtpk_s(P[B],P[B+1])
  #define PAF(k) __builtin_bit_cast(bf16x8,pw##k)
  #define VFR(i) (bf16x8){vlo[i][0],vlo[i][1],vlo[i][2],vlo[i][3],vhi[i][0],vhi[i][1],vhi[i][2],vhi[i][3]}
  #define PIN(x) asm volatile("":"+v"(x))
  #define MX3(a,b,c) __builtin_fmaxf(__builtin_fmaxf((a),(b)),(c))
  #define GAPA(MF,A0,A1,A2,A3,W0,W1,PW) do{ MF; sacc+=A0; sacc+=A1; sacc+=A2; sacc+=A3; PIN(sacc); W0; W1; PIN(PW); SBAR(); }while(0)
  #define EX(v) __builtin_amdgcn_exp2f(v)
  #define GAPB(MF,X,B) do{ MF; X[B]=EX(X[B]); X[B+1]=EX(X[B+1]); X[B+2]=EX(X[B+2]); X[B+3]=EX(X[B+3]); PIN(X); SBAR(); }while(0)
  #define VRD(i) do{ vlo[i]=vtr(vp_+(((i)>>2)*4096+((i)&3)*1024)); vhi[i]=vtr(vp_+(((i)>>2)*4096+((i)&3)*1024+512)); }while(0)
  #define KRD(G,j) do{ if(G){ kload2(kf,kp0+sl_next,j); SBAR(); } }while(0)
  #define STEP(C0,C1,P0,P1,t,GK,GV,GL) do{ SBAR(); \
    const lds_cptr vp_=vp0+sl_prev; \
    VRD(0); SBAR(); float sacc=(P0[0]+P0[1]); \
    GAPA(C0=__builtin_amdgcn_mfma_f32_32x32x16_bf16(kf[0],qr[0],zz,0,0,0), P0[2],P0[3],P0[4],P0[5],     pw0[0]=PKW(P0,0), pw0[1]=PKW(P0,2), pw0); \
    VRD(4); SBAR(); GAPA(C1=__builtin_amdgcn_mfma_f32_32x32x16_bf16(kf[1],qr[0],zz,0,0,0), P0[6],P0[7],P0[8],P0[9],     pw0[2]=PKW(P0,4), pw0[3]=PKW(P0,6), pw0); \
    VRD(1); SBAR(); GAPA(C0=__builtin_amdgcn_mfma_f32_32x32x16_bf16(kf[2],qr[1],C0,0,0,0),   P0[10],P0[11],P0[12],P0[13], pw1[0]=PKW(P0,8), pw1[1]=PKW(P0,10), pw1); \
    VRD(5); SBAR(); GAPA(C1=__builtin_amdgcn_mfma_f32_32x32x16_bf16(kf[3],qr[1],C1,0,0,0),   P0[14],P0[15],P1[0],P1[1],   pw1[2]=PKW(P0,12),pw1[3]=PKW(P0,14), pw1); \
    VRD(2); SBAR(); GAPA(C0=__builtin_amdgcn_mfma_f32_32x32x16_bf16(kf[4],qr[2],C0,0,0,0),   P1[2],P1[3],P1[4],P1[5],     pw2[0]=PKW(P1,0), pw2[1]=PKW(P1,2), pw2); \
    VRD(6); SBAR(); GAPA(C1=__builtin_amdgcn_mfma_f32_32x32x16_bf16(kf[5],qr[2],C1,0,0,0),   P1[6],P1[7],P1[8],P1[9],     pw2[2]=PKW(P1,4), pw2[3]=PKW(P1,6), pw2); \
    VRD(3); SBAR(); GAPA(C0=__builtin_amdgcn_mfma_f32_32x32x16_bf16(kf[6],qr[3],C0,0,0,0),   P1[10],P1[11],P1[12],P1[13], pw3[0]=PKW(P1,8), pw3[1]=PKW(P1,10), pw3); \
    VRD(7); SBAR(); GAPA(C1=__builtin_amdgcn_mfma_f32_32x32x16_bf16(kf[7],qr[3],C1,0,0,0),   P1[14],P1[15],0.f,0.f,       pw3[2]=PKW(P1,12),pw3[3]=PKW(P1,14), pw3); \
    l_reg+=sacc; \
    if(GK){DMA_K((t)+3,sl_cur);} if(GV){DMA_V((t)+1,sl_next);} \
    CMASK(C0,C1,t); \
    SBAR(); \
    GAPB(o[0]=__builtin_amdgcn_mfma_f32_32x32x16_bf16(PAF(0),VFR(0),o[0],0,0,0), C0,0); \
    GAPB(o[1]=__builtin_amdgcn_mfma_f32_32x32x16_bf16(PAF(0),VFR(4),o[1],0,0,0), C0,4); \
    KRD(GL,0); GAPB(o[0]=__builtin_amdgcn_mfma_f32_32x32x16_bf16(PAF(1),VFR(1),o[0],0,0,0), C0,8); \
    KRD(GL,1); GAPB(o[1]=__builtin_amdgcn_mfma_f32_32x32x16_bf16(PAF(1),VFR(5),o[1],0,0,0), C0,12); \
    KRD(GL,2); GAPB(o[0]=__builtin_amdgcn_mfma_f32_32x32x16_bf16(PAF(2),VFR(2),o[0],0,0,0), C1,0); \
    KRD(GL,3); GAPB(o[1]=__builtin_amdgcn_mfma_f32_32x32x16_bf16(PAF(2),VFR(6),o[1],0,0,0), C1,4); \
    GAPB(o[0]=__builtin_amdgcn_mfma_f32_32x32x16_bf16(PAF(3),VFR(3),o[0],0,0,0), C1,8); \
    GAPB(o[1]=__builtin_amdgcn_mfma_f32_32x32x16_bf16(PAF(3),VFR(7),o[1],0,0,0), C1,12); \
    }while(0)
  int t=1;
  #undef CMASK
  #define CMASK(P0,P1,t) do{}while(0)
  for(;t+5<NT;t+=2){
    STEP(pB0,pB1,pA0,pA1,t,true,true,true);     WAIT_BAR(2); ROT();
    STEP(pA0,pA1,pB0,pB1,t+1,true,true,true);   WAIT_BAR(2); ROT();
  }
  #undef CMASK
  #define CMASK(P0,P1,t) do{}while(0)
  #define ENDW(tt) do{ if((tt)+3<NT){WAIT_BAR(2);} else if((tt)+2<NT){WAIT_BAR(1);} else {WAIT_BAR(0);} }while(0)
  for(;t+1<NT;t+=2){
    STEP(pB0,pB1,pA0,pA1,t,(t+3<NT),(t+1<NT),(t+1<NT));       ENDW(t);   ROT();
    STEP(pA0,pA1,pB0,pB1,t+1,(t+4<NT),(t+2<NT),(t+2<NT));     ENDW(t+1); ROT();
  }
  STEP(pB0,pB1,pA0,pA1,NT-1,false,false,false);
  { float sacc=pB0[0]+pB0[1]; _Pragma("unroll") for(int r=2;r<16;++r)sacc+=pB0[r]; _Pragma("unroll") for(int r=0;r<16;++r)sacc+=pB1[r]; l_reg+=sacc;
    pw0=(u32x4){PKW(pB0,0),PKW(pB0,2),PKW(pB0,4),PKW(pB0,6)};pw1=(u32x4){PKW(pB0,8),PKW(pB0,10),PKW(pB0,12),PKW(pB0,14)};pw2=(u32x4){PKW(pB1,0),PKW(pB1,2),PKW(pB1,4),PKW(pB1,6)};pw3=(u32x4){PKW(pB1,8),PKW(pB1,10),PKW(pB1,12),PKW(pB1,14)};
    SBAR(); pv(o,vb0+sl_cur,PAF(0),PAF(1),PAF(2),PAF(3)); }
  #undef PKW
  #undef PAF
  #undef VFR
  #undef PIN
  #undef MX3
  #undef GAPA
  #undef GAPB
  #undef EX
  #undef VRD
  #undef KRD
  #undef STEP
  #undef ENDW
  asm volatile("s_waitcnt lgkmcnt(0)\n\ts_barrier":::"memory");
  if(has_next){
    glds16(ksrc_n,(unsigned)__builtin_amdgcn_readfirstlane(kdst));glds16(vsrc_n,(unsigned)__builtin_amdgcn_readfirstlane(vdst));glds16(ksrc_n+(long)KVBLK*D,(unsigned)__builtin_amdgcn_readfirstlane(kdst+SLOTB));
    #pragma unroll
    for(int d0=0;d0<4;++d0)qr[d0]=*reinterpret_cast<const bf16x8*>(&Qw_n[(long)r32*DM+d0*16+hi*8]);
    glds16(ksrc_n+(long)2*KVBLK*D,(unsigned)__builtin_amdgcn_readfirstlane(kdst+2*SLOTB)); }
  {auto rr=__builtin_amdgcn_permlane32_swap(__float_as_uint(l_reg),__float_as_uint(l_reg),false,false);l_reg=__uint_as_float(rr[0])+__uint_as_float(rr[1]);}
  if(hi==0)wsf[32+r32]=l_reg;asm volatile("s_waitcnt lgkmcnt(0)":::"memory");
  float rli[16];
  #pragma unroll
  for(int r=0;r<16;++r)rli[r]=__builtin_amdgcn_rcpf(wsf[32+crow(r,hi)]);
  bf16*Ow=O+(rowbase+q0+wid*QBLK)*DM+h*D;
  { bf16*stg=(bf16*)(shm+LDS_OST)+wid*2048;
    #pragma unroll
    for(int r=0;r<16;++r){const int orow=crow(r,hi);
      #pragma unroll
      for(int d0=0;d0<2;++d0)stg[orow*64+d0*32+r32]=__float2bfloat16(o[d0][r]*rli[r]);}
    asm volatile("s_waitcnt lgkmcnt(0)":::"memory");
    #pragma unroll
    for(int i=0;i<4;++i){const int row=i*8+(lane>>3),ch=lane&7; const u32x4 v=*(const u32x4*)(stg+row*64+ch*8); ATTN_STORE16(Ow+(long)row*DM+ch*8,v);} }
  asm volatile("s_waitcnt lgkmcnt(0)":::"memory");
  #undef DMA_K
  #undef DMA_V
  #undef CMASK
  #undef START
  #undef RESC
  #undef ROT
}
constexpr int ATTN_LDS_BYTES=LDS_BYTES;
struct AttnOrder { int vcu, G;
  __device__ __forceinline__ bool next(int i,int&b,int&h,int&qb)const{
    int g,u;
    if(G==256){ if(i>=8)return false; g=4*(vcu>>5)+(i>>1); u=2*(vcu&31)+(i&1); }
    else { const int L=i*G+vcu; if(L>=2048)return false; g=L>>6; u=L&63; }
    b=g>>2; h=(g&3)*4+(u>>4); qb=u&15; return true; }
};
#undef SBAR
#undef WAIT_BAR
}

#ifndef XSTAG
#define XSTAG 0
#endif
#ifndef DBG_SKIP
#define DBG_SKIP 0
#endif
#ifndef DBG_P0VAR
#define DBG_P0VAR 0
#endif
#ifndef DBG_SCANVAR
#define DBG_SCANVAR -1
#endif
#ifndef DBG_REPEAT
#define DBG_REPEAT 0
#endif
constexpr int NWAVES = 8;
constexpr int N_LAUNCHES = MK_N_LAUNCHES;
constexpr int PER_PHASE = 8;
static_assert(N_LAUNCHES == 1 || N_LAUNCHES == PER_PHASE, "MK_N_LAUNCHES is 1 or 8");

constexpr int BATCH = 8, SEQ = 4096, D = 1024, M = BATCH * SEQ, DIN = 5632, DFF = 2816;
constexpr float LOG2E = 1.4426950408889634f;

constexpr size_t MiB = 1u << 20;
constexpr size_t WS_CTL = 0, CTL_ZERO_BYTES = 64 * 1024;
constexpr size_t WS_ROPE = 1 * MiB;
constexpr size_t WS_WIN = 2 * MiB, WS_WPR = 13 * MiB, WS_WPA = 15 * MiB, WS_WO = 17 * MiB, WS_WFI = 19 * MiB, WS_WFO = 30 * MiB;
constexpr size_t WS_SSQ = 36 * MiB;
constexpr size_t WS_SCW = 38 * MiB;
constexpr size_t WS_SCB = 42 * MiB;
constexpr size_t WS_U = 48 * MiB;
constexpr size_t WS_RX = 112 * MiB;
constexpr size_t WS_GG = 176 * MiB;
constexpr size_t WS_Q = 240 * MiB;
constexpr size_t WS_K = 368 * MiB, WS_V = 384 * MiB;
constexpr size_t WS_SR = 304 * MiB, WS_SA = 400 * MiB;
constexpr size_t WS_F = 176 * MiB;
constexpr size_t WS_END = 464 * MiB;
static_assert(WS_WFO + (size_t)D * DFF * 2 <= WS_SSQ && WS_SSQ + (size_t)M * 16 * 4 <= WS_U && WS_GG + 64 * MiB == WS_Q && WS_Q + 64 * MiB == WS_SR && WS_SR + 64 * MiB <= WS_K && WS_V + 16 * MiB <= WS_SA, "d_ws map");
constexpr int CW_BAR = 1024;
constexpr int CW_CHK = 12288;

constexpr int RING_OFF = 0, RING_BYTES = 131072;
constexpr int LDSCTL_OFF = RING_BYTES, MISC_OFF = LDSCTL_OFF + 320, LDSCTL_BYTES = 1024, TAB_OFF = LDSCTL_OFF + LDSCTL_BYTES;
constexpr int LDS_BYTES = 163840;
constexpr int SC_XP = 141312;
static_assert(MISC_OFF + 128 <= LDSCTL_OFF + LDSCTL_BYTES && TAB_OFF + (128 + 2048) * 4 <= SC_XP && SC_XP + 8 * 2048 <= LDS_BYTES, "LDS map");

#define GAS __attribute__((address_space(1)))
#define LAS __attribute__((address_space(3)))
typedef unsigned short bf16;
typedef unsigned v4u __attribute__((ext_vector_type(4)));
typedef float f32x4 __attribute__((ext_vector_type(4)));
typedef short bf16x8 __attribute__((ext_vector_type(8)));
typedef GAS unsigned gu32;
typedef GAS unsigned long long gu64;
#define RLX_AGENT __ATOMIC_RELAXED, __HIP_MEMORY_SCOPE_AGENT
#define LDS_WAIT() asm volatile("s_waitcnt lgkmcnt(0)" ::: "memory")
#define VM_WAIT() asm volatile("s_waitcnt vmcnt(0)" ::: "memory")
__device__ __forceinline__ unsigned long long rt() { return __builtin_amdgcn_s_memrealtime(); }
__device__ __forceinline__ unsigned pk2(float lo, float hi) { return pg8::cvt_pk_bf16(lo, hi); }
__device__ __forceinline__ unsigned f2bf(float f) { return pg8::cvt_pk_bf16(f, f) & 0xffffu; }

#define XB_TMO      128
#define XB_XCNT(j)  (256  + 64 * (j))
#define XB_XSUB(j)  (1280 + 64 * (j))
#define XB_XGEN(j)  (2304 + 64 * (j))
#define XB_TOP      3328
#define XB_TOPGEN   3392
#define XCD_BAR_WORDS 3456
#define XB_LSUB(j)  (3456 + 64 * (j))
#define XB_LGEN(j)  (4480 + 64 * (j))
#define XB_QSUB(k)  (5504 + 16 * (k))
#define XB_QGEN(k)  (7552 + 16 * (k))
#define XB_SPIN_CAP (1u << 18)

__device__ __forceinline__ unsigned xb_ld(unsigned* p)              { return __hip_atomic_load(p, __ATOMIC_RELAXED, __HIP_MEMORY_SCOPE_AGENT); }
__device__ __forceinline__ unsigned xb_add(unsigned* p, unsigned v) { return __hip_atomic_fetch_add(p, v, __ATOMIC_RELAXED, __HIP_MEMORY_SCOPE_AGENT); }
__device__ __forceinline__ unsigned xb_xcc_id() { return (unsigned)__builtin_amdgcn_s_getreg((3 << 11) | 20) & 0xFu; }
#define XB_SPIN(cond, bar) do { unsigned _sp = 0; while (cond) { __builtin_amdgcn_s_sleep(1); \
    if ((++_sp & 255u) == 0u) { if (xb_ld(&(bar)[XB_TMO])) break; if (_sp > XB_SPIN_CAP) { atomicAdd(&(bar)[XB_TMO], 1u); break; } } } } while (0)

struct XcdBarrier {
    unsigned* bar; unsigned x;
    volatile LAS unsigned* st;
};

__device__ __forceinline__ XcdBarrier xcd_barrier_post(unsigned* bar, volatile LAS unsigned* st) {
    XcdBarrier b; b.bar = bar; b.x = xb_xcc_id(); b.st = st;
    if (threadIdx.x == 0) (void)xb_add(&bar[XB_XCNT(b.x)], 1u);
    return b;
}
__device__ __forceinline__ void xcd_barrier_complete(unsigned* bar, unsigned x, unsigned& nloc, unsigned& nx) {
    const unsigned G = gridDim.x * gridDim.y * gridDim.z;
    unsigned sum, cnt, mine, sp = 0u;
    for (;;) {
        sum = 0u; cnt = 0u; mine = 0u;
#pragma unroll
        for (unsigned j = 0; j < 16; ++j) { const unsigned c = xb_ld(&bar[XB_XCNT(j)]); sum += c; cnt += (c > 0u) ? 1u : 0u; mine = (j == x) ? c : mine; }
        if (sum == G) break;
        __builtin_amdgcn_s_sleep(1);
        if ((++sp & 255u) == 0u) { if (xb_ld(&bar[XB_TMO])) break; if (sp > XB_SPIN_CAP) { atomicAdd(&bar[XB_TMO], 1u); break; } }
    }
    nloc = mine > 0u ? mine : 1u; nx = cnt > 0u ? cnt : 1u;
}

__device__ __forceinline__ void xcd_barrier(const XcdBarrier& b) {
    asm volatile("s_waitcnt vmcnt(0)" ::: "memory");
    __syncthreads();
    if (threadIdx.x == 0) {
        unsigned* bar = b.bar;
        __builtin_amdgcn_s_waitcnt(0);
        unsigned nloc = b.st[0], nx = b.st[1];
        if (nloc == 0u) { xcd_barrier_complete(bar, b.x, nloc, nx); b.st[0] = nloc; b.st[1] = nx; }
        const unsigned old = xb_add(&bar[XB_XSUB(b.x)], 1u);
        const unsigned gen = old / nloc;
        if (old + 1u == (gen + 1u) * nloc) {
            __builtin_amdgcn_fence(__ATOMIC_RELEASE, "agent");
            asm volatile("s_waitcnt vmcnt(0)" ::: "memory");
            const unsigned og = xb_add(&bar[XB_TOP], 1u);
            const unsigned tg = og / nx;
            if (og + 1u == (tg + 1u) * nx) xb_add(&bar[XB_TOPGEN], 1u);
            else XB_SPIN(xb_ld(&bar[XB_TOPGEN]) == tg, bar);
            __builtin_amdgcn_fence(__ATOMIC_ACQUIRE, "agent");
            xb_add(&bar[XB_XGEN(b.x)], 1u);
            asm volatile("s_waitcnt vmcnt(0)" ::: "memory");
        } else {
            XB_SPIN(xb_ld(&bar[XB_XGEN(b.x)]) == gen, bar);
            __builtin_amdgcn_fence(__ATOMIC_ACQUIRE, "agent");
            asm volatile("s_waitcnt vmcnt(0)" ::: "memory");
        }
    }
    __syncthreads();
}

__device__ __forceinline__ void xcd_barrier_local(const XcdBarrier& b, volatile LAS unsigned* okw) {
    if (okw[0] != 1u) { xcd_barrier(b); return; }
    asm volatile("s_waitcnt vmcnt(0)" ::: "memory");
    __syncthreads();
    if (threadIdx.x == 0) {
        unsigned* bar = b.bar; const unsigned nloc = b.st[0];
        const unsigned old = xb_add(&bar[XB_LSUB(b.x)], 1u), gen = old / nloc;
        if (old + 1u == (gen + 1u) * nloc) xb_add(&bar[XB_LGEN(b.x)], 1u);
        else XB_SPIN(xb_ld(&bar[XB_LGEN(b.x)]) == gen, bar);
        __builtin_amdgcn_fence(__ATOMIC_ACQUIRE, "agent");
        asm volatile("s_waitcnt vmcnt(0)" ::: "memory");
    }
    __syncthreads();
}

__device__ __forceinline__ void xcd_barrier_quad(const XcdBarrier& b, volatile LAS unsigned* okw, unsigned quad) {
    if (okw[0] != 1u) { xcd_barrier(b); return; }
    asm volatile("s_waitcnt vmcnt(0)" ::: "memory");
    __syncthreads();
    if (threadIdx.x == 0) {
        unsigned* bar = b.bar; const unsigned k = b.x * 8u + quad;
        const unsigned old = xb_add(&bar[XB_QSUB(k)], 1u), gen = old >> 2;
        if ((old & 3u) == 3u) xb_add(&bar[XB_QGEN(k)], 1u);
        else XB_SPIN(xb_ld(&bar[XB_QGEN(k)]) == gen, bar);
        __builtin_amdgcn_fence(__ATOMIC_ACQUIRE, "agent");
        asm volatile("s_waitcnt vmcnt(0)" ::: "memory");
    }
    __syncthreads();
}


using pg8::bf_lo; using pg8::bf_hi; using pg8::sigmoid_f;
struct Frame {
    LAS unsigned char* lds;
    volatile LAS unsigned* MISC;
    gu32* ctl;
    int tid, lane, wave;
    int vcu, G;
    const float* x; float* out;
    const float *norm1_g, *w_in, *conv_w, *conv_b, *wa_f, *ba_f, *wx_f, *bx_f, *lam_f, *wa_b, *ba_b, *wx_b, *bx_b, *lam_b, *q_norm_g, *k_norm_g, *p_rnn, *p_attn, *w_o, *norm2_g, *w_ffn_in, *w_ffn_out;
    bf16 *Win_t, *Wpr_t, *Wpa_t, *Wo_t, *Wfi_t, *Wfo_t;
    bf16 *U, *RX, *GG, *HG, *Q, *K, *V, *SR, *SA, *MG, *X1B, *Fb;
    float *ROPE, *SSQ, *SCB; bf16* SCW;
};

__device__ __forceinline__ float wave_sum(float v) {
#pragma unroll
    for (int o = 1; o < 64; o <<= 1) v += __shfl_xor(v, o);
    return v;
}
__device__ __forceinline__ void p0_transpose_item64(const float* W, int K, int N, bf16* WT, int src_a, int src_b, int dst_row0, int k0, const float* kscale, LAS float* scr, int lane, float cs = 1.0f) {
    const int c4 = (lane & 15) * 4, rr = lane >> 4, scol = (c4 < 32 ? src_a : src_b - 32) + c4;
    f32x4 v[16];
#pragma unroll
    for (int i = 0; i < 16; ++i) v[i] = *(const GAS f32x4*)(W + (size_t)(k0 + 4 * i + rr) * N + scol);
#pragma unroll
    for (int i = 0; i < 16; ++i) { const int kk = 4 * i + rr; f32x4 t = v[i] * cs; if (kscale) t = t * kscale[k0 + kk];
        LAS float* d = scr + kk * 65 + c4; d[0] = t.x; d[1] = t.y; d[2] = t.z; d[3] = t.w; }
    LDS_WAIT(); asm volatile("" ::: "memory");
    const int c = lane & 7;
#pragma unroll
    for (int j = 0; j < 8; ++j) { const int n = (lane >> 3) + 8 * j; const LAS float* s = scr + (8 * c) * 65 + n;
        v4u o; o.x = pk2(s[0 * 65], s[1 * 65]); o.y = pk2(s[2 * 65], s[3 * 65]); o.z = pk2(s[4 * 65], s[5 * 65]); o.w = pk2(s[6 * 65], s[7 * 65]);
        *(GAS v4u*)(WT + (size_t)(dst_row0 + n) * K + k0 + 8 * c) = o; }
    LDS_WAIT(); asm volatile("" ::: "memory");
}
template <int NR> __device__ __forceinline__ void rms_rows_to_bf16(Frame& F, const float* xrow, const float* g, bf16* orow) {
    const GAS f32x4* xr = (const GAS f32x4*)xrow + F.lane; const GAS f32x4* gr = (const GAS f32x4*)g + F.lane;
    f32x4 v[NR][4], gg[4]; float rs[NR];
#pragma unroll
    for (int j = 0; j < 4; ++j) gg[j] = gr[64 * j];
#pragma unroll
    for (int r = 0; r < NR; ++r)
#pragma unroll
        for (int j = 0; j < 4; ++j) v[r][j] = __builtin_nontemporal_load(&xr[256 * r + 64 * j]);
#pragma unroll
    for (int r = 0; r < NR; ++r) { float s = 0.f;
#pragma unroll
        for (int j = 0; j < 4; ++j) s += (v[r][j].x * v[r][j].x + v[r][j].y * v[r][j].y) + (v[r][j].z * v[r][j].z + v[r][j].w * v[r][j].w);
        rs[r] = s; }
#pragma unroll
    for (int o = 1; o < 64; o <<= 1)
#pragma unroll
        for (int r = 0; r < NR; ++r) rs[r] += __shfl_xor(rs[r], o);
#pragma unroll
    for (int r = 0; r < NR; ++r) rs[r] = 1.f / sqrtf(rs[r] * (1.f / D) + 1e-6f);
    GAS unsigned long long* o8 = (GAS unsigned long long*)orow + F.lane;
#pragma unroll
    for (int j = 0; j < 4; ++j) { const f32x4 g4 = gg[j];
#pragma unroll
        for (int r = 0; r < NR; ++r) o8[256 * r + 64 * j] = (unsigned long long)pk2(v[r][j].x * rs[r] * g4.x, v[r][j].y * rs[r] * g4.y) | ((unsigned long long)pk2(v[r][j].z * rs[r] * g4.z, v[r][j].w * rs[r] * g4.w) << 32); }
}
template <int VAR> __device__ __forceinline__ void p0_prologue(Frame& F) {
    const int w = F.wave;
    if (VAR != 1) {
        const int gw = F.vcu * NWAVES + w, NGW = F.G * NWAVES;
        for (int m = 4 * gw; m < M; m += 4 * NGW) rms_rows_to_bf16<4>(F, F.x + (size_t)m * D, F.norm1_g, F.U + (size_t)m * D);
    }
    if (VAR != 2) {
        LAS float* scr = (LAS float*)(F.lds + (w < 7 ? RING_OFF + w * 16640 : TAB_OFF));
        const int gw = F.vcu * NWAVES + w, NGW = F.G * NWAVES;
        constexpr int I_IN = (D / 64) * (DIN / 64), I_SQ = (D / 64) * (D / 64), I_FI = I_IN, I_FO = (DFF / 64) * (D / 64);
        constexpr int NITEMS = I_IN + 3 * I_SQ + I_FI + I_FO;
        for (int it = gw; it < NITEMS; it += NGW) {
            int r = it;
            if (r < I_IN) { const int kb = r / (DIN / 64), n0 = 64 * (r % (DIN / 64)), tile = n0 >> 8, pp = n0 & 255;
                int sa = n0, sb = n0 + 32;
                if (tile >= 8 && tile <= 12) { sa = tile * 256 + 64 * ((pp >> 5) & 3) + 32 * (pp >> 7); sb = tile * 256 + 64 * (((pp + 32) >> 5) & 3) + 32 * ((pp + 32) >> 7); }
                p0_transpose_item64(F.w_in, D, DIN, F.Win_t, sa, sb, n0, 64 * kb, nullptr, scr, F.lane, tile >= 14 ? -1.4426950408889634f : 1.0f); continue; } r -= I_IN;
            if (r < I_SQ) { const int n0 = 64 * (r % 16); p0_transpose_item64(F.p_rnn, D, D, F.Wpr_t, n0, n0 + 32, n0, 64 * (r / 16), nullptr, scr, F.lane); continue; } r -= I_SQ;
            if (r < I_SQ) { const int n0 = 64 * (r % 16); p0_transpose_item64(F.p_attn, D, D, F.Wpa_t, n0, n0 + 32, n0, 64 * (r / 16), nullptr, scr, F.lane); continue; } r -= I_SQ;
            if (r < I_SQ) { const int n0 = 64 * (r % 16); p0_transpose_item64(F.w_o, D, D, F.Wo_t, n0, n0 + 32, n0, 64 * (r / 16), nullptr, scr, F.lane); continue; } r -= I_SQ;
            if (r < I_FI) { const int kb = r / (DIN / 64), n0 = 64 * (r % (DIN / 64)), pn = n0 >> 8, pp = n0 & 255;
                const int src = (pp >> 7) * DFF + 128 * pn + (pp & 127);
                p0_transpose_item64(F.w_ffn_in, D, DIN, F.Wfi_t, src, src + 32, n0, 64 * kb, F.norm2_g, scr, F.lane); continue; } r -= I_FI;
            { const int n0 = 64 * (r % 16); p0_transpose_item64(F.w_ffn_out, DFF, D, F.Wfo_t, n0, n0 + 32, n0, 64 * (r / 16), nullptr, scr, F.lane); }
        }
    }
    if (VAR != 3) {
        const int gt = F.vcu * (NWAVES * 64) + F.tid, NTH = F.G * (NWAVES * 64);
        if (gt < 1024) { const int pos = gt >> 4, i = gt & 15; double inv = 1.0; for (int k = 0; k < i; ++k) inv *= 0.5623413251903491;
            const double ang = (double)pos * inv, q = __builtin_rint(ang * 0.6366197723675814);
            double r = __builtin_fma(-q, 1.5707963267948966, ang); r = __builtin_fma(-q, 6.123233995736766e-17, r);
            const double r2 = r * r;
            double sn = 1.0 / 1307674368000.0; sn = sn * r2 - 1.0 / 6227020800.0; sn = sn * r2 + 1.0 / 39916800.0; sn = sn * r2 - 1.0 / 362880.0; sn = sn * r2 + 1.0 / 5040.0; sn = sn * r2 - 1.0 / 120.0; sn = sn * r2 + 1.0 / 6.0; sn = -sn * r2 + 1.0; sn *= r;
            double cs = 1.0 / 20922789888000.0; cs = cs * r2 - 1.0 / 87178291200.0; cs = cs * r2 + 1.0 / 479001600.0; cs = cs * r2 - 1.0 / 3628800.0; cs = cs * r2 + 1.0 / 40320.0; cs = cs * r2 - 1.0 / 720.0; cs = cs * r2 + 1.0 / 24.0; cs = cs * r2 - 0.5; cs = cs * r2 + 1.0;
            const int qi = (int)q & 3; const double c = qi == 0 ? cs : qi == 1 ? -sn : qi == 2 ? -cs : sn, s = qi == 0 ? sn : qi == 1 ? cs : qi == 2 ? -sn : -cs;
            F.ROPE[gt * 2] = (float)c; F.ROPE[gt * 2 + 1] = (float)s; }
        const float *waf_ = F.wa_f, *wab_ = F.wa_b, *wxf_ = F.wx_f, *wxb_ = F.wx_b, *cw_ = F.conv_w, *cb_ = F.conv_b;
#pragma unroll 1
        for (int e16 = gt; e16 < 4096 * 16; e16 += NTH) {
            const int e = e16 >> 4, pt = e16 & 15, gate = e & 1, cc = (e >> 1) & 1023, dir = e >> 11, blk = cc >> 6, col = cc & 63;
            const float* W = (gate ? (dir ? wxb_ : wxf_) : (dir ? wab_ : waf_)) + blk * 4096; float s = 0.f;
#pragma unroll
            for (int i = 4 * pt; i < 4 * pt + 4; ++i) s += cb_[blk * 64 + i] * W[i * 64 + col];
            s += __shfl_xor(s, 1); s += __shfl_xor(s, 2); s += __shfl_xor(s, 4); s += __shfl_xor(s, 8);
            if (pt == 0) F.SCB[e] = s; }
#pragma unroll 2
        for (int e = gt; e < 2 * 16 * 2 * 3072; e += NTH) {
            const int ent = e % 3072, r3 = e / 3072, half = r3 & 1, blk = (r3 >> 1) & 15, dir = r3 >> 5;
            const int nn = ent & 31, hh = (ent >> 5) & 1, sp = (ent >> 6) & 15, cblk = ent >> 10, k = sp >> 2, i0 = 16 * (sp & 3) + 8 * hh, col = half * 32 + nn;
            const float* wa = (dir ? wab_ : waf_) + blk * 4096; const float* wx = (dir ? wxb_ : wxf_) + blk * 4096;
            float v[8];
#pragma unroll
            for (int j = 0; j < 8; ++j) { const int i = i0 + j; const float cwv = cw_[k * 1024 + blk * 64 + i];
                v[j] = cblk == 0 ? -LOG2E * cwv * wa[i * 64 + col] : cblk == 1 ? -LOG2E * cwv * wx[i * 64 + col] : (i == col ? cwv : 0.f); }
            v4u o; o.x = pk2(v[0], v[1]); o.y = pk2(v[2], v[3]); o.z = pk2(v[4], v[5]); o.w = pk2(v[6], v[7]);
            *(GAS v4u*)(F.SCW + (size_t)e * 8) = o; }
    }
}

typedef float f32x16 __attribute__((ext_vector_type(16)));
constexpr int SC_ROWB = 144, SC_TILEB = 260 * SC_ROWB, SC_TILE0 = 0, SC_BW = 2 * SC_TILEB, SC_WAB = SC_BW + 49152, SC_END = SC_WAB + 4096;
static_assert(SC_END <= RING_BYTES, "scan LDS map");
__device__ __forceinline__ int crow16(int r, int hi) { return (r & 3) + 8 * (r >> 2) + 4 * hi; }
template <int DIR, int VAR> __device__ __forceinline__ void scan_sweep(Frame& F, int b, int blk, int half, bf16* HGdst) {
    const int lane = F.lane, w = F.wave, n = lane & 31, hi = lane >> 5, tid = F.tid;
    const int c = blk * 64 + half * 32 + n;
    LAS unsigned char* lds = F.lds;
    const float* wa = (DIR ? F.wa_b : F.wa_f) + blk * 4096; const float* wx = (DIR ? F.wx_b : F.wx_f) + blk * 4096;
    __syncthreads();
    { const GAS v4u* src = (const GAS v4u*)(F.SCW + (size_t)((DIR * 16 + blk) * 2 + half) * 3072 * 8) + tid; v4u t_[6];
#pragma unroll
      for (int i = 0; i < 6; ++i) t_[i] = src[i * (NWAVES * 64)];
#pragma unroll
      for (int i = 0; i < 6; ++i) *(LAS v4u*)(lds + SC_BW + (tid + i * (NWAVES * 64)) * 16) = t_[i]; }
    const float cbr = F.SCB[(DIR * 1024 + c) * 2], cbi = F.SCB[(DIR * 1024 + c) * 2 + 1];
    const float ini_r = -LOG2E * ((DIR ? F.ba_b : F.ba_f)[c] + cbr), ini_i = -LOG2E * ((DIR ? F.bx_b : F.bx_f)[c] + cbi), ini_x = F.conv_b[c];
    float k8;
    { const float lam = (DIR ? F.lam_b : F.lam_f)[c]; const float e = __builtin_amdgcn_exp2f(-fabsf(lam) * LOG2E);
      const float l1p = e < 0.05f ? e * (1.0f + e * (-0.5f + e * (0.33333333f + e * (-0.25f + e * (0.2f + e * (-0.16666667f)))))) : __logf(1.0f + e);
      k8 = 8.0f * (fmaxf(-lam, 0.0f) + l1p); }
    const float ka = -k8 * LOG2E;
    const bf16* rxb = F.RX + (size_t)b * SEQ * D + blk * 64;
    bf16* outb = (bf16*)F.out + (size_t)b * SEQ * D * 2;     const bf16* ggb = F.GG + (size_t)b * SEQ * D; bf16* hgb = HGdst + (size_t)b * SEQ * D;
    v4u pf[5];
#define SC_LOAD(t0_) do { _Pragma("unroll") for (int i_ = 0; i_ < 5; ++i_) { const int p_ = tl + i_ * (NWAVES * 64), t_ = (t0_) - 2 + (p_ >> 3); \
        pf[i_] = (v4u){0u, 0u, 0u, 0u}; if (p_ < 260 * 8 && t_ >= 0 && t_ < SEQ) pf[i_] = *(const GAS v4u*)(rxb + (unsigned)(t_ * D + (p_ & 7) * 8)); } } while (0)
#define SC_WRITE(tile_) do { _Pragma("unroll") for (int i_ = 0; i_ < 5; ++i_) { const int p_ = tl + i_ * (NWAVES * 64); \
        if (p_ < 260 * 8) *(LAS v4u*)(lds + (tile_) + (p_ >> 3) * SC_ROWB + (p_ & 7) * 16) = pf[i_]; } } while (0)
    int tl = tid; unsigned lo_ = (unsigned)(32 * w + 4 * hi) * D + c;
    asm volatile("" : "+v"(tl), "+v"(lo_));
    const bool grpB = w >= 4;
    LAS unsigned char* xb = lds + SC_XP + w * 2048;
    SC_LOAD(DIR ? 15 * 256 : 0); SC_WRITE(SC_TILE0);
    SC_LOAD(DIR ? 14 * 256 : 256);
    float carry = 0.f;
    const int aoff = (32 * w + n) * SC_ROWB + 16 * hi, boff = SC_BW + (hi * 32 + n) * 16;
    f32x16 rp, ip, xo;
#pragma unroll
    for (int q = 0; q < 16; ++q) { rp[q] = 0.f; ip[q] = 0.f; xo[q] = 0.f; }
    float A[16], Bv[16], loA[4], loB[4], hiA[4], hiB[4]; unsigned hg2[16];
#pragma unroll
    for (int q = 0; q < 16; ++q) { A[q] = 0.f; Bv[q] = 0.f; hg2[q] = 0u; }
#pragma unroll
    for (int g = 0; g < 4; ++g) { loA[g] = 0.f; loB[g] = 0.f; hiA[g] = 0.f; hiB[g] = 0.f; }
#pragma unroll 1
    for (int s = 0; s < 34; ++s) {
        asm volatile("" : "+v"(tl), "+v"(lo_));
        __syncthreads();
        const int sm = s - (grpB ? 1 : 0);
        const int ckt = (s - 3) >> 1;
        if (VAR != 4 && !(s & 1)) { const int ckn = (s >> 1) + 1;
            if (ckn < 16) SC_WRITE((ckn & 1) * SC_TILEB);
            if (ckn + 1 < 16) SC_LOAD((DIR ? 15 - (ckn + 1) : ckn + 1) * 256); }
        if (VAR != 3 && (s & 1) && s >= 3) {
            const int t0 = (DIR ? 15 - ckt : ckt) * 256;
            const LAS float* WABr = (const LAS float*)(lds + SC_WAB) + (ckt & 1) * 512;
            float x = carry, cinw = 0.f;
#pragma unroll
            for (int i = 0; i < 8; ++i) { const int ww = DIR ? 7 - i : i; const float a = WABr[(ww * 32 + n) * 2], bq = WABr[(ww * 32 + n) * 2 + 1]; if (ww == w) cinw = x; x = a * x + bq; }
            carry = x;
            x = cinw;
#define SC_OUT(q_, hv_) do { const float o_ = DIR == 0 ? (hv_) : (__uint_as_float(hg2[q_] << 16) + (hv_)) * __uint_as_float(hg2[q_] & 0xffff0000u); \
                *(LAS unsigned short*)(xb + (((q_) & 3) + 8 * ((q_) >> 2) + 4 * hi) * 64 + n * 2) = (unsigned short)f2bf(o_); } while (0)
            if (DIR == 0) {
#pragma unroll
                for (int g = 0; g < 4; ++g) { const float x0 = x, x1 = loA[g] * x0 + loB[g], cin = hi ? x1 : x0; x = hiA[g] * x1 + hiB[g];
#pragma unroll
                    for (int j = 0; j < 4; ++j) SC_OUT(4 * g + j, Bv[4 * g + j] + A[4 * g + j] * cin); }
            } else {
#pragma unroll
                for (int g = 3; g >= 0; --g) { const float x0 = x, x1 = hiA[g] * x0 + hiB[g], cin = hi ? x0 : x1; x = loA[g] * x1 + loB[g];
#pragma unroll
                    for (int j = 0; j < 4; ++j) SC_OUT(4 * g + j, Bv[4 * g + j] + A[4 * g + j] * cin); }
            }
#undef SC_OUT
            { const v4u o0 = *(const LAS v4u*)(xb + lane * 16), o1 = *(const LAS v4u*)(xb + 1024 + lane * 16);
              bf16* dst = (DIR == 0 ? outb : hgb) + (unsigned)(t0 + 32 * w + (lane >> 2)) * D + (blk * 64 + half * 32 + (lane & 3) * 8);
              *(GAS v4u*)dst = o0; *(GAS v4u*)(dst + 16 * D) = o1; }
        }
        if (VAR != 1 && sm >= 0 && !(sm & 1) && (sm >> 1) < 16) {
            unsigned abase = ((sm >> 1) & 1) * SC_TILEB + aoff, bbase = boff;
            asm volatile("" : "+v"(abase), "+v"(bbase));
#pragma unroll
            for (int q = 0; q < 16; ++q) { rp[q] = ini_r; ip[q] = ini_i; xo[q] = ini_x; }
#pragma unroll
            for (int sp = 0; sp < 16; ++sp) {
                const bf16x8 afr = *(const LAS bf16x8*)(lds + abase + (sp >> 2) * SC_ROWB + (sp & 3) * 32);
                const bf16x8 b0 = *(const LAS bf16x8*)(lds + bbase + (0 * 16 + sp) * 1024), b1 = *(const LAS bf16x8*)(lds + bbase + (1 * 16 + sp) * 1024), b2 = *(const LAS bf16x8*)(lds + bbase + (2 * 16 + sp) * 1024);
                rp = __builtin_amdgcn_mfma_f32_32x32x16_bf16(afr, b0, rp, 0, 0, 0);
                ip = __builtin_amdgcn_mfma_f32_32x32x16_bf16(afr, b1, ip, 0, 0, 0);
                xo = __builtin_amdgcn_mfma_f32_32x32x16_bf16(afr, b2, xo, 0, 0, 0);
                if (sp & 1) __builtin_amdgcn_sched_barrier(0);
            }
        }
        if (VAR != 2 && sm >= 1 && (sm & 1) && ((sm - 1) >> 1) < 16) {
            __builtin_amdgcn_s_setprio(1);
            const int ck = (sm - 1) >> 1, t0 = (DIR ? 15 - ck : ck) * 256;
            v4u h0, h1, g0, g1;
            if (DIR && VAR != 5) { const unsigned po = (unsigned)(t0 + 32 * w + (lane >> 2)) * D + (blk * 64 + half * 32 + (lane & 3) * 8);
                h0 = *(const GAS v4u*)(outb + po); h1 = *(const GAS v4u*)(outb + po + 16 * D); g0 = *(const GAS v4u*)(ggb + po); g1 = *(const GAS v4u*)(ggb + po + 16 * D); }
#pragma unroll
            for (int q = 0; q < 16; ++q) {
                const float r = __builtin_amdgcn_rcpf(1.0f + __builtin_amdgcn_exp2f(rp[q])), ig = __builtin_amdgcn_rcpf(1.0f + __builtin_amdgcn_exp2f(ip[q]));
                const float a = __builtin_amdgcn_exp2f(ka * r);
                A[q] = a;
                Bv[q] = __builtin_amdgcn_sqrtf(fmaxf(__builtin_fmaf(-a, a, 1.0f), 0.f)) * ig * xo[q]; }
#pragma unroll
            for (int g = 0; g < 4; ++g) {
                if (DIR == 0) {
#pragma unroll
                    for (int j = 1; j < 4; ++j) { const int q = 4 * g + j; Bv[q] = A[q] * Bv[q - 1] + Bv[q]; A[q] *= A[q - 1]; }
                } else {
#pragma unroll
                    for (int j = 2; j >= 0; --j) { const int q = 4 * g + j; Bv[q] = A[q] * Bv[q + 1] + Bv[q]; A[q] *= A[q + 1]; }
                }
                const float sA = A[4 * g + (DIR ? 0 : 3)], sB = Bv[4 * g + (DIR ? 0 : 3)];
                const auto ra = __builtin_amdgcn_permlane32_swap(__float_as_uint(sA), __float_as_uint(sA), false, false);
                const auto rb = __builtin_amdgcn_permlane32_swap(__float_as_uint(sB), __float_as_uint(sB), false, false);
                loA[g] = __uint_as_float(ra[0]); hiA[g] = __uint_as_float(ra[1]); loB[g] = __uint_as_float(rb[0]); hiB[g] = __uint_as_float(rb[1]);
            }
            float WA = 1.f, WB = 0.f;
            if (DIR == 0) {
#pragma unroll
                for (int g = 0; g < 4; ++g) { WB = loA[g] * WB + loB[g]; WA *= loA[g]; WB = hiA[g] * WB + hiB[g]; WA *= hiA[g]; }
            } else {
#pragma unroll
                for (int g = 3; g >= 0; --g) { WB = hiA[g] * WB + hiB[g]; WA *= hiA[g]; WB = loA[g] * WB + loB[g]; WA *= loA[g]; }
            }
            LAS float* WABw = (LAS float*)(lds + SC_WAB) + (ck & 1) * 512;
            if (hi == 0) { WABw[(w * 32 + n) * 2] = WA; WABw[(w * 32 + n) * 2 + 1] = WB; }
            __builtin_amdgcn_s_setprio(0);
            if (DIR && VAR != 5) {
                *(LAS v4u*)(xb + lane * 16) = h0; *(LAS v4u*)(xb + 1024 + lane * 16) = h1;
#pragma unroll
                for (int q = 0; q < 16; ++q) hg2[q] = (unsigned)*(const LAS unsigned short*)(xb + ((q & 3) + 8 * (q >> 2) + 4 * hi) * 64 + n * 2);
                *(LAS v4u*)(xb + lane * 16) = g0; *(LAS v4u*)(xb + 1024 + lane * 16) = g1;
#pragma unroll
                for (int q = 0; q < 16; ++q) hg2[q] |= (unsigned)*(const LAS unsigned short*)(xb + ((q & 3) + 8 * (q >> 2) + 4 * hi) * 64 + n * 2) << 16;
            }
        }
    }
#undef SC_LOAD
#undef SC_WRITE
}
template <int VAR> __device__ __forceinline__ void scan_item(Frame& F, int item, bf16* HGdst) {
    const int b = item >> 5, blk = (item >> 1) & 15, half = item & 1;
    scan_sweep<0, VAR>(F, b, blk, half, HGdst);
    scan_sweep<1, VAR>(F, b, blk, half, HGdst);
    __syncthreads();
}


struct Args { const float* in[23]; float* out; unsigned char* ws; int ph_lo, ph_hi, li, pad; };
__global__ void __launch_bounds__(NWAVES * 64, 2) skel_fwd(Args args) {
    extern __shared__ __attribute__((aligned(16))) unsigned char lds[];
    Frame F;
    F.lds = (LAS unsigned char*)lds;
    F.MISC = (volatile LAS unsigned*)(F.lds + MISC_OFF);
    F.wave = __builtin_amdgcn_readfirstlane((int)threadIdx.x >> 6); F.lane = lane_id_fresh(); F.tid = F.wave * 64 + F.lane;
    F.G = gridDim.x; { const int bx = blockIdx.x; F.vcu = (F.G % 8 == 0) ? (bx % 8) * (F.G / 8) + bx / 8 : bx; }
#define FILL_FRAME() do { F.lane = lane_id_fresh(); F.tid = F.wave * 64 + F.lane; const __attribute__((address_space(4))) Args* ap_ = (const __attribute__((address_space(4))) Args*)__builtin_amdgcn_kernarg_segment_ptr(); asm volatile("" : "+s"(ap_)); \
    unsigned char* ws = ap_->ws; \
    F.ctl = (gu32*)(ws + WS_CTL); \
    F.x = ap_->in[0]; F.norm1_g = ap_->in[1]; F.w_in = ap_->in[2]; F.conv_w = ap_->in[3]; F.conv_b = ap_->in[4]; F.wa_f = ap_->in[5]; F.ba_f = ap_->in[6]; F.wx_f = ap_->in[7]; F.bx_f = ap_->in[8]; F.lam_f = ap_->in[9]; \
    F.wa_b = ap_->in[10]; F.ba_b = ap_->in[11]; F.wx_b = ap_->in[12]; F.bx_b = ap_->in[13]; F.lam_b = ap_->in[14]; F.q_norm_g = ap_->in[15]; F.k_norm_g = ap_->in[16]; F.p_rnn = ap_->in[17]; F.p_attn = ap_->in[18]; \
    F.w_o = ap_->in[19]; F.norm2_g = ap_->in[20]; F.w_ffn_in = ap_->in[21]; F.w_ffn_out = ap_->in[22]; F.out = ap_->out; \
    F.Win_t = (bf16*)(ws + WS_WIN); F.Wpr_t = (bf16*)(ws + WS_WPR); F.Wpa_t = (bf16*)(ws + WS_WPA); F.Wo_t = (bf16*)(ws + WS_WO); F.Wfi_t = (bf16*)(ws + WS_WFI); F.Wfo_t = (bf16*)(ws + WS_WFO); \
    F.U = (bf16*)(ws + WS_U); F.RX = (bf16*)(ws + WS_RX); F.GG = (bf16*)(ws + WS_GG); F.Q = (bf16*)(ws + WS_Q); F.K = (bf16*)(ws + WS_K); F.V = (bf16*)(ws + WS_V); \
    F.SR = (bf16*)(ws + WS_SR); F.SA = (bf16*)(ws + WS_SA); F.HG = (bf16*)(ws + WS_U); F.MG = (bf16*)(ws + WS_RX); F.X1B = (bf16*)(ws + WS_U); F.Fb = (bf16*)(ws + WS_F); \
    F.ROPE = (float*)(ws + WS_ROPE); F.SSQ = (float*)(ws + WS_SSQ); F.SCB = (float*)(ws + WS_SCB); F.SCW = (bf16*)(ws + WS_SCW); \
    } while (0)
    unsigned char* ws = args.ws;
    F.ctl = (gu32*)(ws + WS_CTL);
    for (int u = F.tid; u < LDSCTL_BYTES / 4; u += NWAVES * 64) ((LAS unsigned*)(F.lds + LDSCTL_OFF))[u] = 0u;
    __syncthreads();
    XcdBarrier bar; bar.bar = (unsigned*)(F.ctl + CW_BAR); bar.x = 0; bar.st = nullptr;
    if (N_LAUNCHES != PER_PHASE) { bar = xcd_barrier_post((unsigned*)(F.ctl + CW_BAR), F.MISC + 8);
        if (threadIdx.x == 0) (void)xb_add((unsigned*)(F.ctl + CW_CHK) + (blockIdx.x & 7) * 16 + bar.x, 1u); }
#define GRID_BAR() do { if (N_LAUNCHES != PER_PHASE) xcd_barrier(bar); } while (0)
#define LOCAL_BAR() do { if (N_LAUNCHES != PER_PHASE) xcd_barrier_local(bar, F.MISC + 12); } while (0)
#define QUAD_BAR() do { if (N_LAUNCHES != PER_PHASE) xcd_barrier_quad(bar, F.MISC + 12, (blockIdx.x >> 3) & 7u); } while (0)
    const int lo = args.ph_lo, hi = args.ph_hi;
#define IN(k) (lo <= (k) && (k) < hi)
#define BOTH(k) (IN(k) && IN((k) + 1))

    if (IN(0) && !(DBG_SKIP & 1)) { FILL_FRAME();
#if DBG_P0VAR > 0
        if (args.pad) p0_prologue<DBG_P0VAR>(F); else
#endif
        p0_prologue<0>(F); if (BOTH(0)) { GRID_BAR();
            if (N_LAUNCHES != PER_PHASE && WGM_BIG == 8 && WGM_SMALL == 8 && F.G == 256) {
                LAS unsigned* cw = (LAS unsigned*)(F.lds + TAB_OFF);
                if (F.tid < 128) cw[F.tid] = xb_ld((unsigned*)(F.ctl + CW_CHK) + F.tid);
                __syncthreads();
                if (F.tid == 0) { unsigned ok = 1u, used = 0u;
                    for (int c = 0; c < 8; ++c) { int hit = -1, nz = 0; for (int p = 0; p < 16; ++p) { const unsigned v = cw[c * 16 + p]; if (v) { ++nz; if (v == 32u) hit = p; } }
                        if (nz != 1 || hit < 0 || ((used >> hit) & 1u)) ok = 0u; else used |= 1u << hit; }
                    F.MISC[12] = ok; }
                __syncthreads();
#if XSTAG > 0
                if (F.MISC[12] == 1u) {
                    const unsigned long long t0_ = __builtin_amdgcn_s_memrealtime(), dt_ = (unsigned long long)(blockIdx.x & 7) * XSTAG;
                    while (__builtin_amdgcn_s_memrealtime() - t0_ < dt_) __builtin_amdgcn_s_sleep(8); }
#endif
            } } }

    if (IN(1) && !(DBG_SKIP & 2)) {
        FILL_FRAME();
        pg8::Gemm g{F.U, F.U, F.Win_t, F.Win_t, M, DIN, D}; pg8::StaticOrder S; S.init(M, DIN, F.G, (int)blockIdx.x, WGM_BIG);
        { LAS float* tl_ = (LAS float*)(F.lds + TAB_OFF);
          *(LAS f32x4*)(tl_ + 128 + 4 * F.tid) = *(const GAS f32x4*)(F.ROPE + 4 * F.tid);
          if (F.tid < 64) tl_[F.tid] = F.q_norm_g[F.tid]; else if (F.tid < 128) tl_[F.tid] = F.k_norm_g[F.tid - 64];
          __syncthreads(); }
        pg8::EpiProj E{F.RX, F.GG, F.Q, F.K, F.V, F.SR, F.SA, (const LAS float*)(F.lds + TAB_OFF), (const LAS float*)(F.lds + TAB_OFF) + 64, (const LAS float*)(F.lds + TAB_OFF) + 128};
        pg8::gemm_phase<pg8::EpiProj, pg8::StaticOrder, true, true>(F.lds + RING_OFF, g, S, E, DBG_EPI2 && args.pad != 0);
        if (BOTH(1)) LOCAL_BAR();
    }

    if (IN(2) && !(DBG_SKIP & 4)) {
        FILL_FRAME();
#if DBG_SCANVAR >= 0
        if (args.pad) { for (int it = F.vcu; it < 256; it += F.G) scan_item<DBG_SCANVAR>(F, it, (bf16*)F.out + (size_t)M * D); }
        else
#endif
        for (int it = F.vcu; it < 256; it += F.G) scan_item<0>(F, it, F.HG);
    }
    if (IN(3) && !(DBG_SKIP & 8)) {
        FILL_FRAME();
        const attn_body::AttnOrder S{F.vcu, F.G};
        int b, h, qb, nb = 0, nh = 0, nqb = 0; attn_body::bf16x8 qr[4];
        bool more = S.next(0, b, h, qb);
        for (int i = 0; more; ++i) { const bool hn = S.next(i + 1, nb, nh, nqb);
            attn_body::attn_unit<8>(b, h, qb, (const attn_body::bf16*)F.Q, (const attn_body::bf16*)F.K, (const attn_body::bf16*)F.V, (attn_body::bf16*)F.Q, (char*)lds + RING_OFF, nb, nh, nqb, hn, i == 0, qr);
            b = nb; h = nh; qb = nqb; more = hn; }
        if (BOTH(3)) LOCAL_BAR();
    }

    if (IN(4) && !(DBG_SKIP & 16)) {
        FILL_FRAME();
        pg8::Gemm g{F.HG, F.Q, F.Wpr_t, F.Wpa_t, M, D, D}; pg8::PairOrder S; S.init(M, D, F.G, (int)blockIdx.x, WGM_SMALL);
        pg8::EpiMerge E{F.SR, F.SA, F.MG};
        pg8::gemm_phase<pg8::EpiMerge, pg8::PairOrder, true, true>(F.lds + RING_OFF, g, S, E);
        if (BOTH(4)) QUAD_BAR();
    }

    if (IN(5) && !(DBG_SKIP & 32)) {
        FILL_FRAME();
        pg8::Gemm g{F.MG, F.MG, F.Wo_t, F.Wo_t, M, D, D}; pg8::StaticOrder S; S.init(M, D, F.G, (int)blockIdx.x, WGM_SMALL);
        pg8::EpiX1 E{F.x, F.X1B, F.SSQ};
        pg8::gemm_phase<pg8::EpiX1, pg8::StaticOrder, true, true>(F.lds + RING_OFF, g, S, E);
        if (BOTH(5)) QUAD_BAR();
    }

    if (IN(6) && !(DBG_SKIP & 64)) {
        FILL_FRAME();
        pg8::Gemm g{F.X1B, F.X1B, F.Wfi_t, F.Wfi_t, M, DIN, D}; pg8::StaticOrder S; S.init(M, DIN, F.G, (int)blockIdx.x, WGM_BIG);
        pg8::EpiFfn E{F.SSQ, F.Fb};
        pg8::gemm_phase<pg8::EpiFfn, pg8::StaticOrder, true, true>(F.lds + RING_OFF, g, S, E, DBG_EPI2 && args.pad != 0);
        if (BOTH(6)) QUAD_BAR();
    }

    if (IN(7) && !(DBG_SKIP & 128)) {
        FILL_FRAME();
        pg8::Gemm g{F.Fb, F.Fb, F.Wfo_t, F.Wfo_t, M, D, DFF, 1024, (size_t)64 * MiB - 16 * 128}; pg8::StaticOrder S; S.init(M, D, F.G, (int)blockIdx.x, WGM_SMALL);
        pg8::EpiOut E{F.X1B, F.out};
        pg8::gemm_phase<pg8::EpiOut, pg8::StaticOrder, true, true>(F.lds + RING_OFF, g, S, E, DBG_EPI2 && args.pad != 0);
    }
#undef IN
#undef BOTH
}


#ifndef DBG_STOP
#define DBG_STOP 0
#endif
#if DBG_STOP
__global__ void dbg_dump(float* out, const unsigned char* ws, int stop) {
    const size_t i = (size_t)blockIdx.x * blockDim.x + threadIdx.x;
    const size_t row = i >> 10, col = i & 1023;
    auto bf = [](const unsigned char* p, size_t idx) { return __uint_as_float((unsigned)((const unsigned short*)p)[idx] << 16); };
    float v = 0.f;
    if (stop == 1) { v = bf(ws + WS_U, i) + 3.f * bf(ws + WS_WIN, i) + 5.f * bf(ws + WS_WFI, i) + 7.f * bf(ws + WS_WPR, i & 1048575) + 11.f * bf(ws + WS_WPA, i & 1048575) + 13.f * bf(ws + WS_WO, i & 1048575) + 17.f * bf(ws + WS_WFO, i % (1024 * 2816)) + ((const float*)(ws + WS_ROPE))[i & 2047]; }
    if (stop == 2) { v = bf(ws + WS_Q, i) + 3.f * bf(ws + WS_GG, i) + 5.f * bf(ws + WS_RX, i) + 7.f * bf(ws + WS_SR, i) + 11.f * bf(ws + WS_SA, i); if (col < 256) v += 13.f * bf(ws + WS_K, row * 256 + col) + 17.f * bf(ws + WS_V, row * 256 + col); }
    if (stop == 3) { v = bf(ws + WS_Q, i) + 3.f * bf(ws + WS_GG, i); }
    if (stop == 31) { v = bf(ws + WS_Q, i); }
    if (stop == 32) { v = bf(ws + WS_GG, i); }
    if (stop == 4) { v = bf(ws + WS_U, i); }
    if (stop == 5) { v = out[i] + 3.f * bf(ws + WS_RX, i) + ((const float*)(ws + WS_SSQ))[i & (32768 * 16 - 1)]; }
    if (stop == 6) { v = bf(ws + WS_F, i) + bf(ws + WS_F, i + (size_t)32768 * 1024) + ((i + (size_t)2 * 32768 * 1024) < (size_t)32768 * 2816 ? bf(ws + WS_F, i + (size_t)2 * 32768 * 1024) : 0.f); }
    out[i] = v;
}
#endif
extern "C" void kernel_launch(void* const* d_in, const int* in_sizes, int n_in, void* d_out, int out_size, void* d_ws, size_t ws_size, hipStream_t stream) {
    static int grid = 0;
    if (grid == 0) {
        if (n_in != 23 || in_sizes[0] != M * D || out_size != M * D || ws_size < WS_END) { fprintf(stderr, "kernel_launch: unexpected shapes (n_in %d, in0 %d, out %d, ws %zu); nothing launched\n", n_in, n_in > 0 ? in_sizes[0] : -1, out_size, ws_size); grid = -1; return; }
        int dev = 0, cus = 0, per_cu = 0;
        if (hipGetDevice(&dev) != hipSuccess || hipDeviceGetAttribute(&cus, hipDeviceAttributeMultiprocessorCount, dev) != hipSuccess) { fprintf(stderr, "kernel_launch: device query failed\n"); grid = -1; return; }
        if (hipFuncSetAttribute((const void*)skel_fwd, hipFuncAttributeMaxDynamicSharedMemorySize, LDS_BYTES) != hipSuccess) { fprintf(stderr, "kernel_launch: hipFuncSetAttribute failed\n"); grid = -1; return; }
        if (hipOccupancyMaxActiveBlocksPerMultiprocessor(&per_cu, (const void*)skel_fwd, NWAVES * 64, LDS_BYTES) != hipSuccess || per_cu < 1) { fprintf(stderr, "kernel_launch: occupancy query reports %d workgroups per CU\n", per_cu); }
        (void)hipGetLastError();
        grid = cus;
    }
    if (grid < 0) return;
    if (hipMemsetAsync((char*)d_ws + WS_CTL, 0, CTL_ZERO_BYTES, stream) != hipSuccess) { fprintf(stderr, "kernel_launch: hipMemsetAsync failed\n"); return; }
    Args a{};
    for (int i = 0; i < 23; ++i) a.in[i] = (const float*)d_in[i];
    a.out = (float*)d_out; a.ws = (unsigned char*)d_ws;
    for (int li = 0; li < N_LAUNCHES; ++li) {
#if DBG_STOP
        if (li >= (DBG_STOP > 10 ? DBG_STOP / 10 : DBG_STOP)) break;
#endif
        a.ph_lo = (N_LAUNCHES == PER_PHASE) ? li : 0; a.ph_hi = (N_LAUNCHES == PER_PHASE) ? li + 1 : PER_PHASE; a.li = li;
        hipLaunchKernelGGL(skel_fwd, dim3(grid), dim3(NWAVES * 64), LDS_BYTES, stream, a);
        if (N_LAUNCHES == PER_PHASE && ((DBG_REPEAT >> li) & 1) && li != 3) { if ((li == 2 && DBG_SCANVAR >= 0) || DBG_EPI2 || (li == 0 && DBG_P0VAR > 0)) a.pad = 1; hipLaunchKernelGGL(skel_fwd, dim3(grid), dim3(NWAVES * 64), LDS_BYTES, stream, a); a.pad = 0; }
        const hipError_t le = hipPeekAtLastError();
        if (le != hipSuccess) { fprintf(stderr, "kernel_launch: launch %d failed: %s\n", li, hipGetErrorName(le)); break; }
    }
    if (N_LAUNCHES == PER_PHASE && (DBG_REPEAT & 256)) for (int li = 5; li < 8; ++li) { a.ph_lo = li; a.ph_hi = li + 1; a.li = li; hipLaunchKernelGGL(skel_fwd, dim3(grid), dim3(NWAVES * 64), LDS_BYTES, stream, a); }
#if DBG_STOP
    hipLaunchKernelGGL(dbg_dump, dim3(M * D / 256), dim3(256), 0, stream, (float*)d_out, (const unsigned char*)d_ws, (int)DBG_STOP);
#endif
}
```
